# Optimizing an MI355X kernel written in HIP

```python
import jax, jax.numpy as jnp
from jax import lax
import numpy as np

D_MODEL = 1024
BATCH = 2
SEQ = 8192
DEPTH = 2

ATT_WIDTH = D_MODEL // 2
ATT_HEADS = 8
HEAD_DIM = ATT_WIDTH // ATT_HEADS
Q_BLOCK = 128
GMLP_WIDTH = D_MODEL // 4
GMLP_GROUPS = 4
GMLP_GROUP_DIM = GMLP_WIDTH // GMLP_GROUPS
CHUNK = 128
CONV_WIDTH = D_MODEL // 4
CONV_GROUPS = 4
CONV_K = 3
MIX_WIDTH = ATT_WIDTH + GMLP_WIDTH + CONV_WIDTH
SPLIT_SIZES = (ATT_WIDTH, ATT_WIDTH, ATT_WIDTH, ATT_HEADS,
               GMLP_WIDTH, GMLP_WIDTH,
               CONV_WIDTH, CONV_WIDTH, CONV_WIDTH)
IN_COLS = sum(SPLIT_SIZES)

PEER_HEADS = 8
N_KEYS = 128
N_EXPERTS = N_KEYS * N_KEYS
PEER_TOPK = 16
D_KEY = 256
D_HALF = D_KEY // 2
PEER_CHUNK = 128

EPS = 1e-6

kernel_name = "hybrid_fox_gmlp_conv_peer"


def rmsnorm(x, g):
    x32 = x.astype(jnp.float32)
    y = x32 * lax.rsqrt(jnp.mean(x32 * x32, axis=-1, keepdims=True) + EPS)
    return (y * g.astype(jnp.float32)).astype(x.dtype)


def forgetting_attention(q, k, v, cum_logf):
    Bn, S, H, dh = q.shape
    nq = S // Q_BLOCK
    scale = dh ** -0.5
    kh = k.transpose(0, 2, 1, 3)
    vh = v.transpose(0, 2, 1, 3)
    Fk = cum_logf.transpose(0, 2, 1)
    qb = q.reshape(Bn, nq, Q_BLOCK, H, dh).transpose(1, 0, 3, 2, 4)
    Fq = Fk.reshape(Bn, H, nq, Q_BLOCK).transpose(2, 0, 1, 3)
    key_pos = jnp.arange(S)

    def block(args):
        q_blk, fq_blk, i = args
        q_pos = i * Q_BLOCK + jnp.arange(Q_BLOCK)
        logits = jnp.einsum('bhqd,bhkd->bhqk', q_blk, kh).astype(jnp.float32) * scale
        logits = logits + fq_blk[..., :, None] - Fk[..., None, :]
        mask = key_pos[None, :] <= q_pos[:, None]
        logits = jnp.where(mask, logits, -1e30)
        p = jax.nn.softmax(logits, axis=-1).astype(vh.dtype)
        return jnp.einsum('bhqk,bhkd->bhqd', p, vh)

    out = lax.map(block, (qb, Fq, jnp.arange(nq)))
    return out.transpose(1, 0, 3, 2, 4).reshape(Bn, S, H * dh)


def chunked_gmlp(zu, zv, sgu_g, w_spatial, b_spatial):
    Bn, S, _ = zu.shape
    u = jax.nn.gelu(zu)
    v = jax.nn.gelu(zv).reshape(Bn, S, GMLP_GROUPS, GMLP_GROUP_DIM)
    v = rmsnorm(v, sgu_g.reshape(GMLP_GROUPS, GMLP_GROUP_DIM))
    v = v.reshape(Bn, S // CHUNK, CHUNK, GMLP_GROUPS, GMLP_GROUP_DIM)
    tril = jnp.tril(jnp.ones((CHUNK, CHUNK), dtype=bool))
    w = jnp.where(tril[None], w_spatial, jnp.zeros_like(w_spatial))
    mixed = jnp.einsum('gts,bcsgd->bctgd', w, v) + b_spatial.T[:, :, None]
    return u * mixed.reshape(Bn, S, GMLP_WIDTH)


def causal_shift(x, n):
    return jnp.pad(x, ((0, 0), (n, 0), (0, 0)))[:, :x.shape[1], :]


def short_gated_conv(h_in, gate_b, gate_c, conv_w):
    z = gate_c * h_in
    y = conv_w[0] * causal_shift(z, 2) + conv_w[1] * causal_shift(z, 1) + conv_w[2] * z
    return gate_b * y


def peer_ffn(h, w_query, sub_keys, expert_u, expert_v):
    Bn, S, D = h.shape
    T = Bn * S
    ht = h.reshape(T, D)
    q = (ht @ w_query).reshape(T, PEER_HEADS, D_KEY)
    s1 = jnp.einsum('thd,kd->thk', q[..., :D_HALF], sub_keys[0]).astype(jnp.float32)
    s2 = jnp.einsum('thd,kd->thk', q[..., D_HALF:], sub_keys[1]).astype(jnp.float32)
    v1, i1 = lax.top_k(s1, PEER_TOPK)
    v2, i2 = lax.top_k(s2, PEER_TOPK)
    cand = (v1[..., :, None] + v2[..., None, :]).reshape(T, PEER_HEADS, PEER_TOPK * PEER_TOPK)
    sc, ci = lax.top_k(cand, PEER_TOPK)
    e_idx = (jnp.take_along_axis(i1, ci // PEER_TOPK, axis=-1) * N_KEYS
             + jnp.take_along_axis(i2, ci % PEER_TOPK, axis=-1))
    gate = jax.nn.softmax(sc, axis=-1).astype(h.dtype)
    nc = T // PEER_CHUNK

    def chunk(args):
        xc, ec, gc = args
        a = jnp.einsum('chkd,cd->chk', expert_u[ec], xc)
        w = jax.nn.gelu(a) * gc
        return jnp.einsum('chk,chkd->cd', w, expert_v[ec])

    out = lax.map(chunk, (ht.reshape(nc, PEER_CHUNK, D),
                          e_idx.reshape(nc, PEER_CHUNK, PEER_HEADS, PEER_TOPK),
                          gate.reshape(nc, PEER_CHUNK, PEER_HEADS, PEER_TOPK)))
    return out.reshape(Bn, S, D)


def setup_inputs(seed: int = 0) -> dict:
    key = jax.random.key(seed)
    ks = jax.random.split(key, 16)
    f32 = jnp.float32
    nrm = lambda k, shp: jax.random.normal(k, shp, dtype=f32)
    return {
        "x": nrm(ks[0], (BATCH, SEQ, D_MODEL)),
        "norm1_g": 1.0 + 0.05 * nrm(ks[1], (DEPTH, D_MODEL)),
        "w_in": nrm(ks[2], (DEPTH, D_MODEL, IN_COLS)) * D_MODEL ** -0.5,
        "b_forget": 3.0 + 0.5 * nrm(ks[3], (DEPTH, ATT_HEADS)),
        "sgu_norm_g": 1.0 + 0.05 * nrm(ks[4], (DEPTH, GMLP_WIDTH)),
        "w_spatial": nrm(ks[5], (DEPTH, GMLP_GROUPS, CHUNK, CHUNK)) * CHUNK ** -0.5,
        "b_spatial": 1.0 + 0.1 * nrm(ks[6], (DEPTH, GMLP_GROUPS, CHUNK)),
        "conv_w": nrm(ks[7], (DEPTH, CONV_K, CONV_WIDTH)) * CONV_K ** -0.5,
        "mix_norm_g": 1.0 + 0.05 * nrm(ks[8], (DEPTH, MIX_WIDTH)),
        "w_out": nrm(ks[9], (DEPTH, MIX_WIDTH, D_MODEL)) * MIX_WIDTH ** -0.5,
        "norm2_g": 1.0 + 0.05 * nrm(ks[10], (DEPTH, D_MODEL)),
        "w_query": nrm(ks[11], (DEPTH, D_MODEL, PEER_HEADS * D_KEY)) * D_MODEL ** -0.5,
        "sub_keys": nrm(ks[12], (DEPTH, 2, N_KEYS, D_HALF)) * D_HALF ** -0.5,
        "expert_u": nrm(ks[13], (DEPTH, N_EXPERTS, D_MODEL)) * D_MODEL ** -0.5,
        "expert_v": nrm(ks[14], (DEPTH, N_EXPERTS, D_MODEL)) * PEER_HEADS ** -0.5,
        "final_g": 1.0 + 0.05 * nrm(ks[15], (D_MODEL,)),
    }


def reference(x, norm1_g, w_in, b_forget, sgu_norm_g, w_spatial, b_spatial, conv_w,
              mix_norm_g, w_out, norm2_g, w_query, sub_keys, expert_u, expert_v, final_g):
    Bn, S, _ = x.shape
    split_at = [int(s) for s in np.cumsum(SPLIT_SIZES)[:-1]]
    for l in range(DEPTH):
        h = rmsnorm(x, norm1_g[l])
        z = h @ w_in[l]
        zq, zk, zv, zf, gu, gv, c_in, c_b, c_c = jnp.split(z, split_at, axis=-1)
        logf = jax.nn.log_sigmoid((zf + b_forget[l]).astype(jnp.float32))
        cum_logf = jnp.cumsum(logf, axis=1)
        shp = (Bn, S, ATT_HEADS, HEAD_DIM)
        o_att = forgetting_attention(zq.reshape(shp), zk.reshape(shp), zv.reshape(shp), cum_logf)
        o_gmlp = chunked_gmlp(gu, gv, sgu_norm_g[l], w_spatial[l], b_spatial[l])
        o_conv = short_gated_conv(c_in, c_b, c_c, conv_w[l])
        g = mix_norm_g[l]
        mixed = jnp.concatenate([
            rmsnorm(o_att, g[:ATT_WIDTH]),
            rmsnorm(o_gmlp, g[ATT_WIDTH:ATT_WIDTH + GMLP_WIDTH]),
            rmsnorm(o_conv, g[ATT_WIDTH + GMLP_WIDTH:]),
        ], axis=-1)
        x = x + mixed @ w_out[l]
        h2 = rmsnorm(x, norm2_g[l])
        x = x + peer_ffn(h2, w_query[l], sub_keys[l], expert_u[l], expert_v[l])
    return rmsnorm(x, final_g)
```

```cpp
#include <hip/hip_runtime.h>
#include <cstdio>
#include <cstdint>

#ifndef MK_N_LAUNCHES
#define MK_N_LAUNCHES 0
#endif

constexpr int D = 1024, NB = 2, S = 8192, T = NB * S, DEPTH = 2;
constexpr int NH = 8, HD = 64, CHUNK = 128;
constexpr int IN_COLS = 2824;
constexpr int OFF_Q = 0, OFF_K = 512, OFF_V = 1024, OFF_F = 1536, OFF_GU = 1544, OFF_GV = 1800, OFF_CI = 2056, OFF_CB = 2312, OFF_CC = 2568;
constexpr int PH = 8, NKEYS = 128, NEXP = 16384, TOPK = 16, DKEY = 256, DHALF = 128;
constexpr float EPS = 1e-6f;
constexpr int NTHR = 512, NWAVES = 8;

constexpr size_t MiB = 1u << 20;
constexpr size_t WS_CTL = 0, CTL_ZERO_BYTES = 1 * MiB;
constexpr size_t WS_F = 1 * MiB;
constexpr size_t WS_EIDX = 2 * MiB;
constexpr size_t WS_GATE = 10 * MiB;
constexpr size_t WS_VN = 18 * MiB;
constexpr size_t WS_H = 34 * MiB;
constexpr size_t WS_MIX = 98 * MiB;
constexpr size_t WS_X1 = 162 * MiB;
constexpr size_t WS_X2 = 226 * MiB;
constexpr size_t WS_Z = 290 * MiB;
constexpr size_t WS_END = 470 * MiB;
constexpr int CW_BAR = 4096;

constexpr int LDS_BYTES = 147456;
constexpr int MISC_OFF = 131072 + 320;

#define GAS __attribute__((address_space(1)))
#define LAS __attribute__((address_space(3)))
typedef GAS unsigned gu32;
#define RLX_AGENT __ATOMIC_RELAXED, __HIP_MEMORY_SCOPE_AGENT

#define XB_TMO      128
#define XB_XCNT(j)  (256  + 64 * (j))
#define XB_XSUB(j)  (1280 + 64 * (j))
#define XB_XGEN(j)  (2304 + 64 * (j))
#define XB_TOP      3328
#define XB_TOPGEN   3392
#define XCD_BAR_WORDS 3456
#define XB_SPIN_CAP (1u << 22)
__device__ __forceinline__ unsigned xb_ld(unsigned* p)              { return __hip_atomic_load(p, __ATOMIC_RELAXED, __HIP_MEMORY_SCOPE_AGENT); }
__device__ __forceinline__ unsigned xb_add(unsigned* p, unsigned v) { return __hip_atomic_fetch_add(p, v, __ATOMIC_RELAXED, __HIP_MEMORY_SCOPE_AGENT); }
__device__ __forceinline__ unsigned xb_xcc_id() { return (unsigned)__builtin_amdgcn_s_getreg((3 << 11) | 20) & 0xFu; }
#define XB_SPIN(cond, bar) do { unsigned _sp = 0; while (cond) { __builtin_amdgcn_s_sleep(1); \
    if ((++_sp & 255u) == 0u) { if (xb_ld(&(bar)[XB_TMO])) break; if (_sp > XB_SPIN_CAP) { atomicAdd(&(bar)[XB_TMO], 1u); break; } } } } while (0)
struct XcdBarrier { unsigned* bar; unsigned x; volatile LAS unsigned* st; };
__device__ __forceinline__ XcdBarrier xcd_barrier_post(unsigned* bar, volatile LAS unsigned* st) {
    XcdBarrier b; b.bar = bar; b.x = xb_xcc_id(); b.st = st;
    if (threadIdx.x == 0) (void)xb_add(&bar[XB_XCNT(b.x)], 1u);
    return b;
}
__device__ __forceinline__ void xcd_barrier_complete(unsigned* bar, unsigned x, unsigned& nloc, unsigned& nx) {
    const unsigned G = gridDim.x * gridDim.y * gridDim.z;
    unsigned sum, cnt, mine, sp = 0u;
    for (;;) {
        sum = 0u; cnt = 0u; mine = 0u;
#pragma unroll
        for (unsigned j = 0; j < 16; ++j) { const unsigned c = xb_ld(&bar[XB_XCNT(j)]); sum += c; cnt += (c > 0u) ? 1u : 0u; mine = (j == x) ? c : mine; }
        if (sum == G) break;
        __builtin_amdgcn_s_sleep(1);
        if ((++sp & 255u) == 0u) { if (xb_ld(&bar[XB_TMO])) break; if (sp > XB_SPIN_CAP) { atomicAdd(&bar[XB_TMO], 1u); break; } }
    }
    nloc = mine > 0u ? mine : 1u; nx = cnt > 0u ? cnt : 1u;
}
__device__ __forceinline__ void xcd_barrier(const XcdBarrier& b) {
    asm volatile("s_waitcnt vmcnt(0)" ::: "memory");
    __syncthreads();
    if (threadIdx.x == 0) {
        unsigned* bar = b.bar;
        __builtin_amdgcn_s_waitcnt(0);
        unsigned nloc = b.st[0], nx = b.st[1];
        if (nloc == 0u) { xcd_barrier_complete(bar, b.x, nloc, nx); b.st[0] = nloc; b.st[1] = nx; }
        const unsigned old = xb_add(&bar[XB_XSUB(b.x)], 1u);
        const unsigned gen = old / nloc;
        if (old + 1u == (gen + 1u) * nloc) {
            __builtin_amdgcn_fence(__ATOMIC_RELEASE, "agent");
            asm volatile("s_waitcnt vmcnt(0)" ::: "memory");
            const unsigned og = xb_add(&bar[XB_TOP], 1u);
            const unsigned tg = og / nx;
            if (og + 1u == (tg + 1u) * nx) xb_add(&bar[XB_TOPGEN], 1u);
            else XB_SPIN(xb_ld(&bar[XB_TOPGEN]) == tg, bar);
            __builtin_amdgcn_fence(__ATOMIC_ACQUIRE, "agent");
            xb_add(&bar[XB_XGEN(b.x)], 1u);
            asm volatile("s_waitcnt vmcnt(0)" ::: "memory");
        } else {
            XB_SPIN(xb_ld(&bar[XB_XGEN(b.x)]) == gen, bar);
            __builtin_amdgcn_fence(__ATOMIC_ACQUIRE, "agent");
            asm volatile("s_waitcnt vmcnt(0)" ::: "memory");
        }
    }
    __syncthreads();
}

__device__ __forceinline__ float wave_sum(float v) {
#pragma unroll
    for (int o = 1; o < 64; o <<= 1) v += __shfl_xor(v, o);
    return v;
}
__device__ __forceinline__ float gelu_tanh(float x) {
    const float u = 0.7978845608028654f * (x + 0.044715f * x * x * x);
    return 0.5f * x * (1.0f + tanhf(u));
}
__device__ __forceinline__ float log_sigmoid(float x) { return fminf(x, 0.f) - log1pf(expf(-fabsf(x))); }

struct Ctx { int tid, lane, wave, bid, nblk; float* lds; };

__device__ __forceinline__ void ph_rmsnorm(const Ctx& c, const float* X, const float* g, float* Y) {
    const int gw = c.bid * NWAVES + c.wave, NGW = c.nblk * NWAVES;
    for (int m = gw; m < T; m += NGW) {
        const float4* xr = (const float4*)(X + (size_t)m * D) + c.lane;
        float4 v[4]; float s = 0.f;
#pragma unroll
        for (int j = 0; j < 4; ++j) { v[j] = xr[64 * j]; s += v[j].x * v[j].x + v[j].y * v[j].y + v[j].z * v[j].z + v[j].w * v[j].w; }
        const float r = rsqrtf(wave_sum(s) * (1.f / D) + EPS);
        float4* yr = (float4*)(Y + (size_t)m * D) + c.lane;
#pragma unroll
        for (int j = 0; j < 4; ++j) { const float4 gg = ((const float4*)g)[c.lane + 64 * j];
            yr[64 * j] = make_float4(v[j].x * r * gg.x, v[j].y * r * gg.y, v[j].z * r * gg.z, v[j].w * r * gg.w); }
    }
}

__device__ __forceinline__ void ph_gemm(const Ctx& c, const float* A, int lda, const float* Bm, int ldb, const float* R, float* C, int ldc, int M, int N, int K) {
    float* As = c.lds;
    float* Bs = c.lds + 16 * 132;
    const int tx = c.tid & 31, ty = c.tid >> 5;
    const int ntm = M / 128, ntn = (N + 127) / 128;
    const int arow = c.tid >> 2, akq = c.tid & 3, bkr = c.tid >> 5, bn4 = c.tid & 31;
    for (int tile = c.bid; tile < ntm * ntn; tile += c.nblk) {
        const int tm = tile / ntn, tn = tile % ntn;
        float acc[8][4];
#pragma unroll
        for (int i = 0; i < 8; ++i)
#pragma unroll
            for (int j = 0; j < 4; ++j) acc[i][j] = 0.f;
        const float* Ap = A + (size_t)(tm * 128 + arow) * lda + akq * 4;
        const int bcol = tn * 128 + bn4 * 4;
        for (int k0 = 0; k0 < K; k0 += 16) {
            const float4 a4 = *(const float4*)(Ap + k0);
            float4 b4 = make_float4(0.f, 0.f, 0.f, 0.f);
            if (bcol < N) b4 = *(const float4*)(Bm + (size_t)(k0 + bkr) * ldb + bcol);
            __syncthreads();
            As[(akq * 4 + 0) * 132 + arow] = a4.x; As[(akq * 4 + 1) * 132 + arow] = a4.y; As[(akq * 4 + 2) * 132 + arow] = a4.z; As[(akq * 4 + 3) * 132 + arow] = a4.w;
            *(float4*)(Bs + bkr * 128 + bn4 * 4) = b4;
            __syncthreads();
#pragma unroll
            for (int kk = 0; kk < 16; ++kk) {
                const float4 a0 = *(const float4*)(As + kk * 132 + ty * 8), a1 = *(const float4*)(As + kk * 132 + ty * 8 + 4);
                const float4 b = *(const float4*)(Bs + kk * 128 + tx * 4);
                const float av[8] = {a0.x, a0.y, a0.z, a0.w, a1.x, a1.y, a1.z, a1.w};
                const float bv[4] = {b.x, b.y, b.z, b.w};
#pragma unroll
                for (int i = 0; i < 8; ++i)
#pragma unroll
                    for (int j = 0; j < 4; ++j) acc[i][j] = fmaf(av[i], bv[j], acc[i][j]);
            }
        }
        const int col = tn * 128 + tx * 4;
        if (col < N) {
#pragma unroll
            for (int i = 0; i < 8; ++i) {
                const size_t off = (size_t)(tm * 128 + ty * 8 + i) * ldc + col;
                float4 o = make_float4(acc[i][0], acc[i][1], acc[i][2], acc[i][3]);
                if (R) { const float4 r = *(const float4*)(R + off); o.x += r.x; o.y += r.y; o.z += r.z; o.w += r.w; }
                *(float4*)(C + off) = o;
            }
        }
    }
}

__device__ __forceinline__ void ph_local(const Ctx& c, const float* Z, const float* bf, const float* sgu_g, const float* conv_w, float* F, float* VN, float* MIX) {
    if (c.bid < NB * NH) {
        const int b = c.bid / NH, h = c.bid % NH;
        const float bias = bf[h];
        float loc[16]; float run = 0.f;
#pragma unroll
        for (int i = 0; i < 16; ++i) { const int s = c.tid * 16 + i; run += log_sigmoid(Z[(size_t)(b * S + s) * IN_COLS + OFF_F + h] + bias); loc[i] = run; }
        c.lds[c.tid] = run;
        __syncthreads();
        if (c.tid == 0) { float a = 0.f; for (int i = 0; i < NTHR; ++i) { const float v = c.lds[i]; c.lds[i] = a; a += v; } }
        __syncthreads();
        const float base = c.lds[c.tid];
#pragma unroll
        for (int i = 0; i < 16; ++i) { const int s = c.tid * 16 + i; F[(size_t)(b * S + s) * NH + h] = base + loc[i]; }
        __syncthreads();
    }
    const int gw = c.bid * NWAVES + c.wave, NGW = c.nblk * NWAVES;
    for (int it = gw; it < T * 4; it += NGW) {
        const int t = it >> 2, g = it & 3;
        const float v = gelu_tanh(Z[(size_t)t * IN_COLS + OFF_GV + g * 64 + c.lane]);
        const float r = rsqrtf(wave_sum(v * v) * (1.f / 64.f) + EPS);
        VN[(size_t)t * 256 + g * 64 + c.lane] = v * r * sgu_g[g * 64 + c.lane];
    }
    for (int it = c.bid * NTHR + c.tid; it < T * 256; it += c.nblk * NTHR) {
        const int t = it >> 8, ch = it & 255, s = t & (S - 1);
        const float* zr = Z + (size_t)t * IN_COLS;
        const float z0 = zr[OFF_CC + ch] * zr[OFF_CI + ch];
        const float z1 = (s >= 1) ? (zr - IN_COLS)[OFF_CC + ch] * (zr - IN_COLS)[OFF_CI + ch] : 0.f;
        const float z2 = (s >= 2) ? (zr - 2 * IN_COLS)[OFF_CC + ch] * (zr - 2 * IN_COLS)[OFF_CI + ch] : 0.f;
        const float y = conv_w[ch] * z2 + conv_w[256 + ch] * z1 + conv_w[512 + ch] * z0;
        MIX[(size_t)t * D + 768 + ch] = zr[OFF_CB + ch] * y;
    }
}

__device__ __forceinline__ void ph_gmlp(const Ctx& c, const float* Z, const float* VN, const float* wsp, const float* bsp, float* MIX) {
    for (int it = c.bid * NTHR + c.tid; it < T * 256; it += c.nblk * NTHR) {
        const int t = it >> 8, ch = it & 255, g = ch >> 6, tau = t & (CHUNK - 1), t0 = t - tau;
        const float* w = wsp + ((size_t)g * CHUNK + tau) * CHUNK;
        float acc = 0.f;
        for (int s = 0; s <= tau; ++s) acc = fmaf(w[s], VN[(size_t)(t0 + s) * 256 + ch], acc);
        const float u = gelu_tanh(Z[(size_t)t * IN_COLS + OFF_GU + ch]);
        MIX[(size_t)t * D + 512 + ch] = u * (acc + bsp[g * CHUNK + tau]);
    }
}

__device__ __forceinline__ void ph_attn(const Ctx& c, const float* Z, const float* F, float* MIX) {
    float* Ks = c.lds; float* Vs = c.lds + 4096; float* Fs = c.lds + 8192;
    for (int u = c.bid; u < NB * NH * 16; u += c.nblk) {
        const int qblk = 15 - (u & 15), bh = u >> 4, b = bh >> 3, h = bh & 7;
        const int t = qblk * 512 + c.tid;
        const float* zrow = Z + (size_t)(b * S + t) * IN_COLS;
        float q[64], o[64];
#pragma unroll
        for (int d4 = 0; d4 < 16; ++d4) { const float4 v = *(const float4*)(zrow + OFF_Q + h * 64 + d4 * 4); q[d4 * 4] = v.x * 0.125f; q[d4 * 4 + 1] = v.y * 0.125f; q[d4 * 4 + 2] = v.z * 0.125f; q[d4 * 4 + 3] = v.w * 0.125f; }
#pragma unroll
        for (int d = 0; d < 64; ++d) o[d] = 0.f;
        const float Ft = F[(size_t)(b * S + t) * NH + h];
        float m = -1e30f, l = 0.f;
        const int nkt = (qblk * 512 + 512) / 64;
        for (int kt = 0; kt < nkt; ++kt) {
            __syncthreads();
#pragma unroll
            for (int i = 0; i < 2; ++i) { const int idx = c.tid + i * 512, r = idx >> 4, c4 = idx & 15;
                const float* kr = Z + (size_t)(b * S + kt * 64 + r) * IN_COLS + h * 64 + c4 * 4;
                *(float4*)(Ks + r * 64 + c4 * 4) = *(const float4*)(kr + OFF_K);
                *(float4*)(Vs + r * 64 + c4 * 4) = *(const float4*)(kr + OFF_V); }
            if (c.tid < 64) Fs[c.tid] = F[(size_t)(b * S + kt * 64 + c.tid) * NH + h];
            __syncthreads();
            if (kt * 64 <= t) {
                for (int g = 0; g < 8; ++g) {
                    float sc[8]; float gm = -1e30f;
#pragma unroll
                    for (int j = 0; j < 8; ++j) {
                        const float* kr = Ks + (g * 8 + j) * 64; float dsum = 0.f;
#pragma unroll
                        for (int d = 0; d < 64; ++d) dsum = fmaf(q[d], kr[d], dsum);
                        const int key = kt * 64 + g * 8 + j;
                        float sv = dsum + (Ft - Fs[g * 8 + j]);
                        if (key > t) sv = -1e30f;
                        sc[j] = sv; gm = fmaxf(gm, sv);
                    }
                    const float mn = fmaxf(m, gm), scale = expf(m - mn);
                    l *= scale;
#pragma unroll
                    for (int d = 0; d < 64; ++d) o[d] *= scale;
#pragma unroll
                    for (int j = 0; j < 8; ++j) {
                        const float p = expf(sc[j] - mn); l += p;
                        const float* vr = Vs + (g * 8 + j) * 64;
#pragma unroll
                        for (int d = 0; d < 64; ++d) o[d] = fmaf(p, vr[d], o[d]);
                    }
                    m = mn;
                }
            }
        }
        const float rl = 1.f / l;
        float* orow = MIX + (size_t)(b * S + t) * D + h * 64;
#pragma unroll
        for (int d4 = 0; d4 < 16; ++d4) *(float4*)(orow + d4 * 4) = make_float4(o[d4 * 4] * rl, o[d4 * 4 + 1] * rl, o[d4 * 4 + 2] * rl, o[d4 * 4 + 3] * rl);
    }
}

__device__ __forceinline__ void ph_mixnorm(const Ctx& c, float* MIX, const float* g) {
    const int gw = c.bid * NWAVES + c.wave, NGW = c.nblk * NWAVES;
    for (int m = gw; m < T; m += NGW) {
        float4* xr = (float4*)(MIX + (size_t)m * D) + c.lane;
        float4 v[4];
#pragma unroll
        for (int j = 0; j < 4; ++j) v[j] = xr[64 * j];
        float sa = 0.f;
#pragma unroll
        for (int j = 0; j < 2; ++j) sa += v[j].x * v[j].x + v[j].y * v[j].y + v[j].z * v[j].z + v[j].w * v[j].w;
        const float sb = v[2].x * v[2].x + v[2].y * v[2].y + v[2].z * v[2].z + v[2].w * v[2].w;
        const float sc = v[3].x * v[3].x + v[3].y * v[3].y + v[3].z * v[3].z + v[3].w * v[3].w;
        const float ra = rsqrtf(wave_sum(sa) * (1.f / 512.f) + EPS), rb = rsqrtf(wave_sum(sb) * (1.f / 256.f) + EPS), rc = rsqrtf(wave_sum(sc) * (1.f / 256.f) + EPS);
#pragma unroll
        for (int j = 0; j < 4; ++j) { const float r = j < 2 ? ra : (j == 2 ? rb : rc); const float4 gg = ((const float4*)g)[c.lane + 64 * j];
            xr[64 * j] = make_float4(v[j].x * r * gg.x, v[j].y * r * gg.y, v[j].z * r * gg.z, v[j].w * r * gg.w); }
    }
}

__device__ __forceinline__ void tk_insert(float (&v)[16], int (&ix)[16], float s, int k) {
    if (s > v[15]) {
        v[15] = s; ix[15] = k;
#pragma unroll
        for (int j = 15; j > 0; --j) {
            const bool sw = v[j] > v[j - 1];
            const float a = v[j], bq = v[j - 1]; const int ia = ix[j], ib = ix[j - 1];
            v[j - 1] = sw ? a : bq; v[j] = sw ? bq : a; ix[j - 1] = sw ? ia : ib; ix[j] = sw ? ib : ia;
        }
    }
}
__device__ __forceinline__ void tk_half(const float* q, const float* skl, float (&v)[16], int (&ix)[16]) {
    float qr[128];
#pragma unroll
    for (int d4 = 0; d4 < 32; ++d4) { const float4 x = *(const float4*)(q + d4 * 4); qr[d4 * 4] = x.x; qr[d4 * 4 + 1] = x.y; qr[d4 * 4 + 2] = x.z; qr[d4 * 4 + 3] = x.w; }
#pragma unroll
    for (int j = 0; j < 16; ++j) { v[j] = -INFINITY; ix[j] = 0; }
    for (int k = 0; k < NKEYS; ++k) {
        const float4* kr = (const float4*)(skl + k * DHALF); float s = 0.f;
#pragma unroll
        for (int d4 = 0; d4 < 32; ++d4) { const float4 kk = kr[d4]; s = fmaf(qr[d4 * 4], kk.x, s); s = fmaf(qr[d4 * 4 + 1], kk.y, s); s = fmaf(qr[d4 * 4 + 2], kk.z, s); s = fmaf(qr[d4 * 4 + 3], kk.w, s); }
        tk_insert(v, ix, s, k);
    }
}
__device__ __forceinline__ void ph_topk1(const Ctx& c, const float* Q, const float* sk, float* TV, int* TI) {
    for (int i = c.tid; i < 2 * NKEYS * DHALF / 4; i += NTHR) ((float4*)c.lds)[i] = ((const float4*)sk)[i];
    __syncthreads();
    for (int it = c.bid * NTHR + c.tid; it < T * PH * 2; it += c.nblk * NTHR) {
        const int half = it & 1;
        float v[16]; int ix[16];
        tk_half(Q + (size_t)it * DHALF, c.lds + half * NKEYS * DHALF, v, ix);
#pragma unroll
        for (int j = 0; j < 16; ++j) { TV[(size_t)it * 16 + j] = v[j]; TI[(size_t)it * 16 + j] = ix[j]; }
    }
    __syncthreads();
}
__device__ __forceinline__ void ph_topk2(const Ctx& c, const float* TV, const int* TI, int* EIDX, float* GATE) {
    for (int it = c.bid * NTHR + c.tid; it < T * PH; it += c.nblk * NTHR) {
        float v1[16], v2[16]; int i1[16], i2[16];
#pragma unroll
        for (int j = 0; j < 16; ++j) { v1[j] = TV[(size_t)it * 32 + j]; v2[j] = TV[(size_t)it * 32 + 16 + j]; i1[j] = TI[(size_t)it * 32 + j]; i2[j] = TI[(size_t)it * 32 + 16 + j]; }
        float cv[16]; int ci[16];
#pragma unroll
        for (int j = 0; j < 16; ++j) { cv[j] = -INFINITY; ci[j] = 0; }
#pragma unroll
        for (int a = 0; a < 16; ++a)
#pragma unroll
            for (int b = 0; b < 16; ++b)
                if ((a + 1) * (b + 1) <= 16) tk_insert(cv, ci, v1[a] + v2[b], i1[a] * NKEYS + i2[b]);
        float sum = 0.f, e[16];
#pragma unroll
        for (int j = 0; j < 16; ++j) { e[j] = expf(cv[j] - cv[0]); sum += e[j]; }
        const float rs = 1.f / sum;
#pragma unroll
        for (int j = 0; j < 16; ++j) { EIDX[(size_t)it * 16 + j] = ci[j]; GATE[(size_t)it * 16 + j] = e[j] * rs; }
    }
}

__device__ __forceinline__ void ph_peer(const Ctx& c, const float* H2, const int* EIDX, const float* GATE, const float* U, const float* V, const float* X1, float* X2) {
    const int gw = c.bid * NWAVES + c.wave, NGW = c.nblk * NWAVES;
    for (int t = gw; t < T; t += NGW) {
        const float4* hr = (const float4*)(H2 + (size_t)t * D) + c.lane;
        float4 h[4], acc[4];
#pragma unroll
        for (int j = 0; j < 4; ++j) { h[j] = hr[64 * j]; acc[j] = make_float4(0.f, 0.f, 0.f, 0.f); }
#pragma unroll 4
        for (int k = 0; k < PH * TOPK; ++k) {
            const int e = __builtin_amdgcn_readfirstlane(EIDX[(size_t)t * 128 + k]);
            const float g = GATE[(size_t)t * 128 + k];
            const float4* ur = (const float4*)(U + (size_t)e * D) + c.lane;
            const float4* vr = (const float4*)(V + (size_t)e * D) + c.lane;
            float p = 0.f;
#pragma unroll
            for (int j = 0; j < 4; ++j) { const float4 u = ur[64 * j]; p += u.x * h[j].x + u.y * h[j].y + u.z * h[j].z + u.w * h[j].w; }
            const float w = gelu_tanh(wave_sum(p)) * g;
#pragma unroll
            for (int j = 0; j < 4; ++j) { const float4 vv = vr[64 * j]; acc[j].x += w * vv.x; acc[j].y += w * vv.y; acc[j].z += w * vv.z; acc[j].w += w * vv.w; }
        }
        const float4* xr = (const float4*)(X1 + (size_t)t * D) + c.lane;
        float4* yr = (float4*)(X2 + (size_t)t * D) + c.lane;
#pragma unroll
        for (int j = 0; j < 4; ++j) { const float4 x = xr[64 * j]; yr[64 * j] = make_float4(x.x + acc[j].x, x.y + acc[j].y, x.z + acc[j].z, x.w + acc[j].w); }
    }
}

constexpr int PH_PER_LAYER = 11, N_PHASES = DEPTH * PH_PER_LAYER + 1;
struct Args { const float* in[16]; float* out; unsigned char* ws; int ph_lo, ph_hi; };

__global__ void __launch_bounds__(NTHR, 2) fwd_kernel(Args args) {
    extern __shared__ __attribute__((aligned(16))) unsigned char lds_raw[];
    Ctx c; c.tid = threadIdx.x; c.lane = c.tid & 63; c.wave = __builtin_amdgcn_readfirstlane(c.tid >> 6); c.bid = blockIdx.x; c.nblk = gridDim.x; c.lds = (float*)lds_raw;
    volatile LAS unsigned* MISC = (volatile LAS unsigned*)((LAS unsigned char*)lds_raw + MISC_OFF);
    if (c.tid < 32) MISC[c.tid] = 0u;
    __syncthreads();
    unsigned char* ws = args.ws;
    XcdBarrier bar; bar.bar = (unsigned*)(ws + WS_CTL) + CW_BAR; bar.x = 0; bar.st = nullptr;
    const bool multi = (args.ph_hi - args.ph_lo) > 1;
    if (multi) bar = xcd_barrier_post((unsigned*)(ws + WS_CTL) + CW_BAR, MISC + 8);

    const float* x = args.in[0];
    float* F = (float*)(ws + WS_F); int* EIDX = (int*)(ws + WS_EIDX); float* GATE = (float*)(ws + WS_GATE); float* VN = (float*)(ws + WS_VN);
    float* H = (float*)(ws + WS_H); float* MIX = (float*)(ws + WS_MIX); float* X1 = (float*)(ws + WS_X1); float* X2 = (float*)(ws + WS_X2); float* Z = (float*)(ws + WS_Z);

#define RUN(k, body) do { const int k_ = (k); if (args.ph_lo <= k_ && k_ < args.ph_hi) { body; if (k_ + 1 < args.ph_hi) xcd_barrier(bar); } } while (0)
#define LAYER(l) { \
        const int p0 = l * PH_PER_LAYER; \
        const float* xin = (l == 0) ? x : X2; \
        RUN(p0 + 0, ph_rmsnorm(c, xin, args.in[1] + (size_t)l * D, H)); \
        RUN(p0 + 1, ph_gemm(c, H, D, args.in[2] + (size_t)l * D * IN_COLS, IN_COLS, nullptr, Z, IN_COLS, T, IN_COLS, D)); \
        RUN(p0 + 2, ph_local(c, Z, args.in[3] + l * NH, args.in[4] + l * 256, args.in[7] + l * 3 * 256, F, VN, MIX)); \
        RUN(p0 + 3, ph_attn(c, Z, F, MIX); ph_gmlp(c, Z, VN, args.in[5] + (size_t)l * 4 * CHUNK * CHUNK, args.in[6] + l * 4 * CHUNK, MIX)); \
        RUN(p0 + 4, ph_mixnorm(c, MIX, args.in[8] + (size_t)l * D)); \
        RUN(p0 + 5, ph_gemm(c, MIX, D, args.in[9] + (size_t)l * D * D, D, xin, X1, D, T, D, D)); \
        RUN(p0 + 6, ph_rmsnorm(c, X1, args.in[10] + (size_t)l * D, H)); \
        RUN(p0 + 7, ph_gemm(c, H, D, args.in[11] + (size_t)l * D * (PH * DKEY), PH * DKEY, nullptr, Z, PH * DKEY, T, PH * DKEY, D)); \
        RUN(p0 + 8, ph_topk1(c, Z, args.in[12] + (size_t)l * 2 * NKEYS * DHALF, VN, (int*)MIX)); \
        RUN(p0 + 9, ph_topk2(c, VN, (const int*)MIX, EIDX, GATE)); \
        RUN(p0 + 10, ph_peer(c, H, EIDX, GATE, args.in[13] + (size_t)l * NEXP * D, args.in[14] + (size_t)l * NEXP * D, X1, X2)); \
    }
    LAYER(0)
    LAYER(1)
#undef LAYER
    RUN(DEPTH * PH_PER_LAYER, ph_rmsnorm(c, X2, args.in[15], args.out));
#undef RUN
}

extern "C" void kernel_launch(void* const* d_in, const int* in_sizes, int n_in, void* d_out, int out_size, void* d_ws, size_t ws_size, hipStream_t stream) {
    static int grid = 0;
    if (grid == 0) {
        if (n_in != 16 || out_size != T * D || ws_size < WS_END) { fprintf(stderr, "kernel_launch: unexpected shapes (n_in %d out %d ws %zu)\n", n_in, out_size, ws_size); grid = -1; return; }
        int dev = 0, cus = 0, per_cu = 0;
        hipGetDevice(&dev); hipDeviceGetAttribute(&cus, hipDeviceAttributeMultiprocessorCount, dev);
        hipFuncSetAttribute((const void*)fwd_kernel, hipFuncAttributeMaxDynamicSharedMemorySize, LDS_BYTES);
        hipOccupancyMaxActiveBlocksPerMultiprocessor(&per_cu, (const void*)fwd_kernel, NTHR, LDS_BYTES);
        (void)hipGetLastError();
        if (per_cu < 1) { fprintf(stderr, "kernel_launch: occupancy query says %d\n", per_cu); }
        grid = cus;
    }
    if (grid < 0) return;
    hipMemsetAsync((char*)d_ws + WS_CTL, 0, CTL_ZERO_BYTES, stream);
    Args a{};
    for (int i = 0; i < 16; ++i) a.in[i] = (const float*)d_in[i];
    a.out = (float*)d_out; a.ws = (unsigned char*)d_ws;
    if (MK_N_LAUNCHES == 1) {
        a.ph_lo = 0; a.ph_hi = N_PHASES;
        hipLaunchKernelGGL(fwd_kernel, dim3(grid), dim3(NTHR), LDS_BYTES, stream, a);
    } else {
        for (int ph = 0; ph < N_PHASES; ++ph) { a.ph_lo = ph; a.ph_hi = ph + 1; hipLaunchKernelGGL(fwd_kernel, dim3(grid), dim3(NTHR), LDS_BYTES, stream, a); }
    }
}
```

```cpp
#include <hip/hip_runtime.h>
#include <cstdio>
#include <cstdint>

#ifndef MK_N_LAUNCHES
#define MK_N_LAUNCHES 1
#endif

constexpr int D = 1024, NB = 2, S = 8192, T = NB * S, DEPTH = 2;
constexpr int NH = 8, HD = 64, CHUNK = 128;
constexpr int IN_COLS = 2824;
constexpr int OFF_Q = 0, OFF_K = 512, OFF_V = 1024, OFF_F = 1536, OFF_GU = 1544, OFF_GV = 1800, OFF_CI = 2056, OFF_CB = 2312, OFF_CC = 2568;
constexpr int PH = 8, NKEYS = 128, NEXP = 16384, TOPK = 16, DKEY = 256, DHALF = 128;
constexpr float EPS = 1e-6f;
constexpr int NTHR = 512, NWAVES = 8;

constexpr size_t MiB = 1u << 20;
constexpr size_t WS_CTL = 0, CTL_ZERO_BYTES = 1 * MiB;
constexpr size_t WS_F = 1 * MiB;
constexpr size_t WS_EIDX = 2 * MiB;
constexpr size_t WS_GATE = 10 * MiB;
constexpr size_t WS_VN = 18 * MiB;
constexpr size_t WS_H = 34 * MiB;
constexpr size_t WS_MIX = 98 * MiB;
constexpr size_t WS_X1 = 162 * MiB;
constexpr size_t WS_X2 = 226 * MiB;
constexpr size_t WS_Z = 290 * MiB;
constexpr size_t WS_END = 470 * MiB;
constexpr int CW_BAR = 4096;

constexpr int LDS_BYTES = 147456;
constexpr int MISC_OFF = 131072 + 320;

#define GAS __attribute__((address_space(1)))
#define LAS __attribute__((address_space(3)))
typedef GAS unsigned gu32;
#define RLX_AGENT __ATOMIC_RELAXED, __HIP_MEMORY_SCOPE_AGENT

#define XB_TMO      128
#define XB_XCNT(j)  (256  + 64 * (j))
#define XB_XSUB(j)  (1280 + 64 * (j))
#define XB_XGEN(j)  (2304 + 64 * (j))
#define XB_TOP      3328
#define XB_TOPGEN   3392
#define XCD_BAR_WORDS 3456
#define XB_SPIN_CAP (1u << 22)
__device__ __forceinline__ unsigned xb_ld(unsigned* p)              { return __hip_atomic_load(p, __ATOMIC_RELAXED, __HIP_MEMORY_SCOPE_AGENT); }
__device__ __forceinline__ unsigned xb_add(unsigned* p, unsigned v) { return __hip_atomic_fetch_add(p, v, __ATOMIC_RELAXED, __HIP_MEMORY_SCOPE_AGENT); }
__device__ __forceinline__ unsigned xb_xcc_id() { return (unsigned)__builtin_amdgcn_s_getreg((3 << 11) | 20) & 0xFu; }
#define XB_SPIN(cond, bar) do { unsigned _sp = 0; while (cond) { __builtin_amdgcn_s_sleep(1); \
    if ((++_sp & 255u) == 0u) { if (xb_ld(&(bar)[XB_TMO])) break; if (_sp > XB_SPIN_CAP) { atomicAdd(&(bar)[XB_TMO], 1u); break; } } } } while (0)
struct XcdBarrier { unsigned* bar; unsigned x; volatile LAS unsigned* st; };
__device__ __forceinline__ XcdBarrier xcd_barrier_post(unsigned* bar, volatile LAS unsigned* st) {
    XcdBarrier b; b.bar = bar; b.x = xb_xcc_id(); b.st = st;
    if (threadIdx.x == 0) (void)xb_add(&bar[XB_XCNT(b.x)], 1u);
    return b;
}
__device__ __forceinline__ void xcd_barrier_complete(unsigned* bar, unsigned x, unsigned& nloc, unsigned& nx) {
    const unsigned G = gridDim.x * gridDim.y * gridDim.z;
    unsigned sum, cnt, mine, sp = 0u;
    for (;;) {
        sum = 0u; cnt = 0u; mine = 0u;
#pragma unroll
        for (unsigned j = 0; j < 16; ++j) { const unsigned c = xb_ld(&bar[XB_XCNT(j)]); sum += c; cnt += (c > 0u) ? 1u : 0u; mine = (j == x) ? c : mine; }
        if (sum == G) break;
        __builtin_amdgcn_s_sleep(1);
        if ((++sp & 255u) == 0u) { if (xb_ld(&bar[XB_TMO])) break; if (sp > XB_SPIN_CAP) { atomicAdd(&bar[XB_TMO], 1u); break; } }
    }
    nloc = mine > 0u ? mine : 1u; nx = cnt > 0u ? cnt : 1u;
}
__device__ __forceinline__ void xcd_barrier(const XcdBarrier& b) {
    asm volatile("s_waitcnt vmcnt(0)" ::: "memory");
    __syncthreads();
    if (threadIdx.x == 0) {
        unsigned* bar = b.bar;
        __builtin_amdgcn_s_waitcnt(0);
        unsigned nloc = b.st[0], nx = b.st[1];
        if (nloc == 0u) { xcd_barrier_complete(bar, b.x, nloc, nx); b.st[0] = nloc; b.st[1] = nx; }
        const unsigned old = xb_add(&bar[XB_XSUB(b.x)], 1u);
        const unsigned gen = old / nloc;
        if (old + 1u == (gen + 1u) * nloc) {
            __builtin_amdgcn_fence(__ATOMIC_RELEASE, "agent");
            asm volatile("s_waitcnt vmcnt(0)" ::: "memory");
            const unsigned og = xb_add(&bar[XB_TOP], 1u);
            const unsigned tg = og / nx;
            if (og + 1u == (tg + 1u) * nx) xb_add(&bar[XB_TOPGEN], 1u);
            else XB_SPIN(xb_ld(&bar[XB_TOPGEN]) == tg, bar);
            __builtin_amdgcn_fence(__ATOMIC_ACQUIRE, "agent");
            xb_add(&bar[XB_XGEN(b.x)], 1u);
            asm volatile("s_waitcnt vmcnt(0)" ::: "memory");
        } else {
            XB_SPIN(xb_ld(&bar[XB_XGEN(b.x)]) == gen, bar);
            __builtin_amdgcn_fence(__ATOMIC_ACQUIRE, "agent");
            asm volatile("s_waitcnt vmcnt(0)" ::: "memory");
        }
    }
    __syncthreads();
}

__device__ __forceinline__ float wave_sum(float v) {
#pragma unroll
    for (int o = 1; o < 64; o <<= 1) v += __shfl_xor(v, o);
    return v;
}
__device__ __forceinline__ float gelu_tanh(float x) {
    const float u = 0.7978845608028654f * (x + 0.044715f * x * x * x);
    return 0.5f * x * (1.0f + tanhf(u));
}
__device__ __forceinline__ float log_sigmoid(float x) { return fminf(x, 0.f) - log1pf(expf(-fabsf(x))); }

struct Ctx { int tid, lane, wave, bid, nblk; float* lds; };

__device__ __forceinline__ void ph_rmsnorm(const Ctx& c, const float* X, const float* g, float* Y) {
    const int gw = c.bid * NWAVES + c.wave, NGW = c.nblk * NWAVES;
    for (int m = gw; m < T; m += NGW) {
        const float4* xr = (const float4*)(X + (size_t)m * D) + c.lane;
        float4 v[4]; float s = 0.f;
#pragma unroll
        for (int j = 0; j < 4; ++j) { v[j] = xr[64 * j]; s += v[j].x * v[j].x + v[j].y * v[j].y + v[j].z * v[j].z + v[j].w * v[j].w; }
        const float r = rsqrtf(wave_sum(s) * (1.f / D) + EPS);
        float4* yr = (float4*)(Y + (size_t)m * D) + c.lane;
#pragma unroll
        for (int j = 0; j < 4; ++j) { const float4 gg = ((const float4*)g)[c.lane + 64 * j];
            yr[64 * j] = make_float4(v[j].x * r * gg.x, v[j].y * r * gg.y, v[j].z * r * gg.z, v[j].w * r * gg.w); }
    }
}

__device__ __forceinline__ void ph_gemm(const Ctx& c, const float* A, int lda, const float* Bm, int ldb, const float* R, float* C, int ldc, int M, int N, int K) {
    float* As = c.lds;
    float* Bs = c.lds + 16 * 132;
    const int tx = c.tid & 31, ty = c.tid >> 5;
    const int ntm = M / 128, ntn = (N + 127) / 128;
    const int arow = c.tid >> 2, akq = c.tid & 3, bkr = c.tid >> 5, bn4 = c.tid & 31;
    for (int tile = c.bid; tile < ntm * ntn; tile += c.nblk) {
        const int tm = tile / ntn, tn = tile % ntn;
        float acc[8][4];
#pragma unroll
        for (int i = 0; i < 8; ++i)
#pragma unroll
            for (int j = 0; j < 4; ++j) acc[i][j] = 0.f;
        const float* Ap = A + (size_t)(tm * 128 + arow) * lda + akq * 4;
        const int bcol = tn * 128 + bn4 * 4;
        for (int k0 = 0; k0 < K; k0 += 16) {
            const float4 a4 = *(const float4*)(Ap + k0);
            float4 b4 = make_float4(0.f, 0.f, 0.f, 0.f);
            if (bcol < N) b4 = *(const float4*)(Bm + (size_t)(k0 + bkr) * ldb + bcol);
            __syncthreads();
            As[(akq * 4 + 0) * 132 + arow] = a4.x; As[(akq * 4 + 1) * 132 + arow] = a4.y; As[(akq * 4 + 2) * 132 + arow] = a4.z; As[(akq * 4 + 3) * 132 + arow] = a4.w;
            *(float4*)(Bs + bkr * 128 + bn4 * 4) = b4;
            __syncthreads();
#pragma unroll
            for (int kk = 0; kk < 16; ++kk) {
                const float4 a0 = *(const float4*)(As + kk * 132 + ty * 8), a1 = *(const float4*)(As + kk * 132 + ty * 8 + 4);
                const float4 b = *(const float4*)(Bs + kk * 128 + tx * 4);
                const float av[8] = {a0.x, a0.y, a0.z, a0.w, a1.x, a1.y, a1.z, a1.w};
                const float bv[4] = {b.x, b.y, b.z, b.w};
#pragma unroll
                for (int i = 0; i < 8; ++i)
#pragma unroll
                    for (int j = 0; j < 4; ++j) acc[i][j] = fmaf(av[i], bv[j], acc[i][j]);
            }
        }
        const int col = tn * 128 + tx * 4;
        if (col < N) {
#pragma unroll
            for (int i = 0; i < 8; ++i) {
                const size_t off = (size_t)(tm * 128 + ty * 8 + i) * ldc + col;
                float4 o = make_float4(acc[i][0], acc[i][1], acc[i][2], acc[i][3]);
                if (R) { const float4 r = *(const float4*)(R + off); o.x += r.x; o.y += r.y; o.z += r.z; o.w += r.w; }
                *(float4*)(C + off) = o;
            }
        }
    }
}

__device__ __forceinline__ void ph_local(const Ctx& c, const float* Z, const float* bf, const float* sgu_g, const float* conv_w, float* F, float* VN, float* MIX) {
    if (c.bid < NB * NH) {
        const int b = c.bid / NH, h = c.bid % NH;
        const float bias = bf[h];
        float loc[16]; float run = 0.f;
#pragma unroll
        for (int i = 0; i < 16; ++i) { const int s = c.tid * 16 + i; run += log_sigmoid(Z[(size_t)(b * S + s) * IN_COLS + OFF_F + h] + bias); loc[i] = run; }
        c.lds[c.tid] = run;
        __syncthreads();
        if (c.tid == 0) { float a = 0.f; for (int i = 0; i < NTHR; ++i) { const float v = c.lds[i]; c.lds[i] = a; a += v; } }
        __syncthreads();
        const float base = c.lds[c.tid];
#pragma unroll
        for (int i = 0; i < 16; ++i) { const int s = c.tid * 16 + i; F[(size_t)(b * S + s) * NH + h] = base + loc[i]; }
        __syncthreads();
    }
    const int gw = c.bid * NWAVES + c.wave, NGW = c.nblk * NWAVES;
    for (int it = gw; it < T * 4; it += NGW) {
        const int t = it >> 2, g = it & 3;
        const float v = gelu_tanh(Z[(size_t)t * IN_COLS + OFF_GV + g * 64 + c.lane]);
        const float r = rsqrtf(wave_sum(v * v) * (1.f / 64.f) + EPS);
        VN[(size_t)t * 256 + g * 64 + c.lane] = v * r * sgu_g[g * 64 + c.lane];
    }
    for (int it = c.bid * NTHR + c.tid; it < T * 256; it += c.nblk * NTHR) {
        const int t = it >> 8, ch = it & 255, s = t & (S - 1);
        const float* zr = Z + (size_t)t * IN_COLS;
        const float z0 = zr[OFF_CC + ch] * zr[OFF_CI + ch];
        const float z1 = (s >= 1) ? (zr - IN_COLS)[OFF_CC + ch] * (zr - IN_COLS)[OFF_CI + ch] : 0.f;
        const float z2 = (s >= 2) ? (zr - 2 * IN_COLS)[OFF_CC + ch] * (zr - 2 * IN_COLS)[OFF_CI + ch] : 0.f;
        const float y = conv_w[ch] * z2 + conv_w[256 + ch] * z1 + conv_w[512 + ch] * z0;
        MIX[(size_t)t * D + 768 + ch] = zr[OFF_CB + ch] * y;
    }
}

__device__ __forceinline__ void ph_gmlp(const Ctx& c, const float* Z, const float* VN, const float* wsp, const float* bsp, float* MIX) {
    for (int it = c.bid * NTHR + c.tid; it < T * 256; it += c.nblk * NTHR) {
        const int t = it >> 8, ch = it & 255, g = ch >> 6, tau = t & (CHUNK - 1), t0 = t - tau;
        const float* w = wsp + ((size_t)g * CHUNK + tau) * CHUNK;
        float acc = 0.f;
        for (int s = 0; s <= tau; ++s) acc = fmaf(w[s], VN[(size_t)(t0 + s) * 256 + ch], acc);
        const float u = gelu_tanh(Z[(size_t)t * IN_COLS + OFF_GU + ch]);
        MIX[(size_t)t * D + 512 + ch] = u * (acc + bsp[g * CHUNK + tau]);
    }
}

__device__ __forceinline__ void ph_attn(const Ctx& c, const float* Z, const float* F, float* MIX) {
    float* Ks = c.lds; float* Vs = c.lds + 4096; float* Fs = c.lds + 8192;
    for (int u = c.bid; u < NB * NH * 16; u += c.nblk) {
        const int qblk = 15 - (u & 15), bh = u >> 4, b = bh >> 3, h = bh & 7;
        const int t = qblk * 512 + c.tid;
        const float* zrow = Z + (size_t)(b * S + t) * IN_COLS;
        float q[64], o[64];
#pragma unroll
        for (int d4 = 0; d4 < 16; ++d4) { const float4 v = *(const float4*)(zrow + OFF_Q + h * 64 + d4 * 4); q[d4 * 4] = v.x * 0.125f; q[d4 * 4 + 1] = v.y * 0.125f; q[d4 * 4 + 2] = v.z * 0.125f; q[d4 * 4 + 3] = v.w * 0.125f; }
#pragma unroll
        for (int d = 0; d < 64; ++d) o[d] = 0.f;
        const float Ft = F[(size_t)(b * S + t) * NH + h];
        float m = -1e30f, l = 0.f;
        const int nkt = (qblk * 512 + 512) / 64;
        for (int kt = 0; kt < nkt; ++kt) {
            __syncthreads();
#pragma unroll
            for (int i = 0; i < 2; ++i) { const int idx = c.tid + i * 512, r = idx >> 4, c4 = idx & 15;
                const float* kr = Z + (size_t)(b * S + kt * 64 + r) * IN_COLS + h * 64 + c4 * 4;
                *(float4*)(Ks + r * 64 + c4 * 4) = *(const float4*)(kr + OFF_K);
                *(float4*)(Vs + r * 64 + c4 * 4) = *(const float4*)(kr + OFF_V); }
            if (c.tid < 64) Fs[c.tid] = F[(size_t)(b * S + kt * 64 + c.tid) * NH + h];
            __syncthreads();
            if (kt * 64 <= t) {
                for (int g = 0; g < 8; ++g) {
                    float sc[8]; float gm = -1e30f;
#pragma unroll
                    for (int j = 0; j < 8; ++j) {
                        const float* kr = Ks + (g * 8 + j) * 64; float dsum = 0.f;
#pragma unroll
                        for (int d = 0; d < 64; ++d) dsum = fmaf(q[d], kr[d], dsum);
                        const int key = kt * 64 + g * 8 + j;
                        float sv = dsum + (Ft - Fs[g * 8 + j]);
                        if (key > t) sv = -1e30f;
                        sc[j] = sv; gm = fmaxf(gm, sv);
                    }
                    const float mn = fmaxf(m, gm), scale = expf(m - mn);
                    l *= scale;
#pragma unroll
                    for (int d = 0; d < 64; ++d) o[d] *= scale;
#pragma unroll
                    for (int j = 0; j < 8; ++j) {
                        const float p = expf(sc[j] - mn); l += p;
                        const float* vr = Vs + (g * 8 + j) * 64;
#pragma unroll
                        for (int d = 0; d < 64; ++d) o[d] = fmaf(p, vr[d], o[d]);
                    }
                    m = mn;
                }
            }
        }
        const float rl = 1.f / l;
        float* orow = MIX + (size_t)(b * S + t) * D + h * 64;
#pragma unroll
        for (int d4 = 0; d4 < 16; ++d4) *(float4*)(orow + d4 * 4) = make_float4(o[d4 * 4] * rl, o[d4 * 4 + 1] * rl, o[d4 * 4 + 2] * rl, o[d4 * 4 + 3] * rl);
    }
}

__device__ __forceinline__ void ph_mixnorm(const Ctx& c, float* MIX, const float* g) {
    const int gw = c.bid * NWAVES + c.wave, NGW = c.nblk * NWAVES;
    for (int m = gw; m < T; m += NGW) {
        float4* xr = (float4*)(MIX + (size_t)m * D) + c.lane;
        float4 v[4];
#pragma unroll
        for (int j = 0; j < 4; ++j) v[j] = xr[64 * j];
        float sa = 0.f;
#pragma unroll
        for (int j = 0; j < 2; ++j) sa += v[j].x * v[j].x + v[j].y * v[j].y + v[j].z * v[j].z + v[j].w * v[j].w;
        const float sb = v[2].x * v[2].x + v[2].y * v[2].y + v[2].z * v[2].z + v[2].w * v[2].w;
        const float sc = v[3].x * v[3].x + v[3].y * v[3].y + v[3].z * v[3].z + v[3].w * v[3].w;
        const float ra = rsqrtf(wave_sum(sa) * (1.f / 512.f) + EPS), rb = rsqrtf(wave_sum(sb) * (1.f / 256.f) + EPS), rc = rsqrtf(wave_sum(sc) * (1.f / 256.f) + EPS);
#pragma unroll
        for (int j = 0; j < 4; ++j) { const float r = j < 2 ? ra : (j == 2 ? rb : rc); const float4 gg = ((const float4*)g)[c.lane + 64 * j];
            xr[64 * j] = make_float4(v[j].x * r * gg.x, v[j].y * r * gg.y, v[j].z * r * gg.z, v[j].w * r * gg.w); }
    }
}

__device__ __forceinline__ void tk_insert(float (&v)[16], int (&ix)[16], float s, int k) {
    if (s > v[15]) {
        v[15] = s; ix[15] = k;
#pragma unroll
        for (int j = 15; j > 0; --j) {
            const bool sw = v[j] > v[j - 1];
            const float a = v[j], bq = v[j - 1]; const int ia = ix[j], ib = ix[j - 1];
            v[j - 1] = sw ? a : bq; v[j] = sw ? bq : a; ix[j - 1] = sw ? ia : ib; ix[j] = sw ? ib : ia;
        }
    }
}
__device__ __forceinline__ void tk_half(const float* q, const float* skl, float (&v)[16], int (&ix)[16]) {
    float qr[128];
#pragma unroll
    for (int d4 = 0; d4 < 32; ++d4) { const float4 x = *(const float4*)(q + d4 * 4); qr[d4 * 4] = x.x; qr[d4 * 4 + 1] = x.y; qr[d4 * 4 + 2] = x.z; qr[d4 * 4 + 3] = x.w; }
#pragma unroll
    for (int j = 0; j < 16; ++j) { v[j] = -INFINITY; ix[j] = 0; }
    for (int k = 0; k < NKEYS; ++k) {
        const float4* kr = (const float4*)(skl + k * DHALF); float s = 0.f;
#pragma unroll
        for (int d4 = 0; d4 < 32; ++d4) { const float4 kk = kr[d4]; s = fmaf(qr[d4 * 4], kk.x, s); s = fmaf(qr[d4 * 4 + 1], kk.y, s); s = fmaf(qr[d4 * 4 + 2], kk.z, s); s = fmaf(qr[d4 * 4 + 3], kk.w, s); }
        tk_insert(v, ix, s, k);
    }
}
__device__ __forceinline__ void ph_topk1(const Ctx& c, const float* Q, const float* sk, float* TV, int* TI) {
    for (int i = c.tid; i < 2 * NKEYS * DHALF / 4; i += NTHR) ((float4*)c.lds)[i] = ((const float4*)sk)[i];
    __syncthreads();
    for (int it = c.bid * NTHR + c.tid; it < T * PH * 2; it += c.nblk * NTHR) {
        const int half = it & 1;
        float v[16]; int ix[16];
        tk_half(Q + (size_t)it * DHALF, c.lds + half * NKEYS * DHALF, v, ix);
#pragma unroll
        for (int j = 0; j < 16; ++j) { TV[(size_t)it * 16 + j] = v[j]; TI[(size_t)it * 16 + j] = ix[j]; }
    }
    __syncthreads();
}
__device__ __forceinline__ void ph_topk2(const Ctx& c, const float* TV, const int* TI, int* EIDX, float* GATE) {
    for (int it = c.bid * NTHR + c.tid; it < T * PH; it += c.nblk * NTHR) {
        float v1[16], v2[16]; int i1[16], i2[16];
#pragma unroll
        for (int j = 0; j < 16; ++j) { v1[j] = TV[(size_t)it * 32 + j]; v2[j] = TV[(size_t)it * 32 + 16 + j]; i1[j] = TI[(size_t)it * 32 + j]; i2[j] = TI[(size_t)it * 32 + 16 + j]; }
        float cv[16]; int ci[16];
#pragma unroll
        for (int j = 0; j < 16; ++j) { cv[j] = -INFINITY; ci[j] = 0; }
#pragma unroll
        for (int a = 0; a < 16; ++a)
#pragma unroll
            for (int b = 0; b < 16; ++b)
                if ((a + 1) * (b + 1) <= 16) tk_insert(cv, ci, v1[a] + v2[b], i1[a] * NKEYS + i2[b]);
        float sum = 0.f, e[16];
#pragma unroll
        for (int j = 0; j < 16; ++j) { e[j] = expf(cv[j] - cv[0]); sum += e[j]; }
        const float rs = 1.f / sum;
#pragma unroll
        for (int j = 0; j < 16; ++j) { EIDX[(size_t)it * 16 + j] = ci[j]; GATE[(size_t)it * 16 + j] = e[j] * rs; }
    }
}

__device__ __forceinline__ void ph_peer(const Ctx& c, const float* H2, const int* EIDX, const float* GATE, const float* U, const float* V, const float* X1, float* X2) {
    const int gw = c.bid * NWAVES + c.wave, NGW = c.nblk * NWAVES;
    for (int t = gw; t < T; t += NGW) {
        const float4* hr = (const float4*)(H2 + (size_t)t * D) + c.lane;
        float4 h[4], acc[4];
#pragma unroll
        for (int j = 0; j < 4; ++j) { h[j] = hr[64 * j]; acc[j] = make_float4(0.f, 0.f, 0.f, 0.f); }
#pragma unroll 4
        for (int k = 0; k < PH * TOPK; ++k) {
            const int e = __builtin_amdgcn_readfirstlane(EIDX[(size_t)t * 128 + k]);
            const float g = GATE[(size_t)t * 128 + k];
            const float4* ur = (const float4*)(U + (size_t)e * D) + c.lane;
            const float4* vr = (const float4*)(V + (size_t)e * D) + c.lane;
            float p = 0.f;
#pragma unroll
            for (int j = 0; j < 4; ++j) { const float4 u = ur[64 * j]; p += u.x * h[j].x + u.y * h[j].y + u.z * h[j].z + u.w * h[j].w; }
            const float w = gelu_tanh(wave_sum(p)) * g;
#pragma unroll
            for (int j = 0; j < 4; ++j) { const float4 vv = vr[64 * j]; acc[j].x += w * vv.x; acc[j].y += w * vv.y; acc[j].z += w * vv.z; acc[j].w += w * vv.w; }
        }
        const float4* xr = (const float4*)(X1 + (size_t)t * D) + c.lane;
        float4* yr = (float4*)(X2 + (size_t)t * D) + c.lane;
#pragma unroll
        for (int j = 0; j < 4; ++j) { const float4 x = xr[64 * j]; yr[64 * j] = make_float4(x.x + acc[j].x, x.y + acc[j].y, x.z + acc[j].z, x.w + acc[j].w); }
    }
}

constexpr int PH_PER_LAYER = 11, N_PHASES = DEPTH * PH_PER_LAYER + 1;
struct Args { const float* in[16]; float* out; unsigned char* ws; int ph_lo, ph_hi; };

__global__ void __launch_bounds__(NTHR, 2) fwd_kernel(Args args) {
    extern __shared__ __attribute__((aligned(16))) unsigned char lds_raw[];
    Ctx c; c.tid = threadIdx.x; c.lane = c.tid & 63; c.wave = __builtin_amdgcn_readfirstlane(c.tid >> 6); c.bid = blockIdx.x; c.nblk = gridDim.x; c.lds = (float*)lds_raw;
    volatile LAS unsigned* MISC = (volatile LAS unsigned*)((LAS unsigned char*)lds_raw + MISC_OFF);
    if (c.tid < 32) MISC[c.tid] = 0u;
    __syncthreads();
    unsigned char* ws = args.ws;
    XcdBarrier bar; bar.bar = (unsigned*)(ws + WS_CTL) + CW_BAR; bar.x = 0; bar.st = nullptr;
    const bool multi = (args.ph_hi - args.ph_lo) > 1;
    if (multi) bar = xcd_barrier_post((unsigned*)(ws + WS_CTL) + CW_BAR, MISC + 8);

    const float* x = args.in[0];
    float* F = (float*)(ws + WS_F); int* EIDX = (int*)(ws + WS_EIDX); float* GATE = (float*)(ws + WS_GATE); float* VN = (float*)(ws + WS_VN);
    float* H = (float*)(ws + WS_H); float* MIX = (float*)(ws + WS_MIX); float* X1 = (float*)(ws + WS_X1); float* X2 = (float*)(ws + WS_X2); float* Z = (float*)(ws + WS_Z);

#define RUN(k, body) do { const int k_ = (k); if (args.ph_lo <= k_ && k_ < args.ph_hi) { body; if (k_ + 1 < args.ph_hi) xcd_barrier(bar); } } while (0)
#define LAYER(l) { \
        const int p0 = l * PH_PER_LAYER; \
        const float* xin = (l == 0) ? x : X2; \
        RUN(p0 + 0, ph_rmsnorm(c, xin, args.in[1] + (size_t)l * D, H)); \
        RUN(p0 + 1, ph_gemm(c, H, D, args.in[2] + (size_t)l * D * IN_COLS, IN_COLS, nullptr, Z, IN_COLS, T, IN_COLS, D)); \
        RUN(p0 + 2, ph_local(c, Z, args.in[3] + l * NH, args.in[4] + l * 256, args.in[7] + l * 3 * 256, F, VN, MIX)); \
        RUN(p0 + 3, ph_attn(c, Z, F, MIX); ph_gmlp(c, Z, VN, args.in[5] + (size_t)l * 4 * CHUNK * CHUNK, args.in[6] + l * 4 * CHUNK, MIX)); \
        RUN(p0 + 4, ph_mixnorm(c, MIX, args.in[8] + (size_t)l * D)); \
        RUN(p0 + 5, ph_gemm(c, MIX, D, args.in[9] + (size_t)l * D * D, D, xin, X1, D, T, D, D)); \
        RUN(p0 + 6, ph_rmsnorm(c, X1, args.in[10] + (size_t)l * D, H)); \
        RUN(p0 + 7, ph_gemm(c, H, D, args.in[11] + (size_t)l * D * (PH * DKEY), PH * DKEY, nullptr, Z, PH * DKEY, T, PH * DKEY, D)); \
        RUN(p0 + 8, ph_topk1(c, Z, args.in[12] + (size_t)l * 2 * NKEYS * DHALF, VN, (int*)MIX)); \
        RUN(p0 + 9, ph_topk2(c, VN, (const int*)MIX, EIDX, GATE)); \
        RUN(p0 + 10, ph_peer(c, H, EIDX, GATE, args.in[13] + (size_t)l * NEXP * D, args.in[14] + (size_t)l * NEXP * D, X1, X2)); \
    }
    LAYER(0)
    LAYER(1)
#undef LAYER
    RUN(DEPTH * PH_PER_LAYER, ph_rmsnorm(c, X2, args.in[15], args.out));
#undef RUN
}

extern "C" void kernel_launch(void* const* d_in, const int* in_sizes, int n_in, void* d_out, int out_size, void* d_ws, size_t ws_size, hipStream_t stream) {
    static int grid = 0;
    if (grid == 0) {
        if (n_in != 16 || out_size != T * D || ws_size < WS_END) { fprintf(stderr, "kernel_launch: unexpected shapes (n_in %d out %d ws %zu)\n", n_in, out_size, ws_size); grid = -1; return; }
        int dev = 0, cus = 0, per_cu = 0;
        hipGetDevice(&dev); hipDeviceGetAttribute(&cus, hipDeviceAttributeMultiprocessorCount, dev);
        hipFuncSetAttribute((const void*)fwd_kernel, hipFuncAttributeMaxDynamicSharedMemorySize, LDS_BYTES);
        hipOccupancyMaxActiveBlocksPerMultiprocessor(&per_cu, (const void*)fwd_kernel, NTHR, LDS_BYTES);
        (void)hipGetLastError();
        if (per_cu < 1) { fprintf(stderr, "kernel_launch: occupancy query says %d\n", per_cu); }
        grid = cus;
    }
    if (grid < 0) return;
    hipMemsetAsync((char*)d_ws + WS_CTL, 0, CTL_ZERO_BYTES, stream);
    Args a{};
    for (int i = 0; i < 16; ++i) a.in[i] = (const float*)d_in[i];
    a.out = (float*)d_out; a.ws = (unsigned char*)d_ws;
    if (MK_N_LAUNCHES == 1) {
        a.ph_lo = 0; a.ph_hi = N_PHASES;
        hipLaunchKernelGGL(fwd_kernel, dim3(grid), dim3(NTHR), LDS_BYTES, stream, a);
    } else {
        for (int ph = 0; ph < N_PHASES; ++ph) { a.ph_lo = ph; a.ph_hi = ph + 1; hipLaunchKernelGGL(fwd_kernel, dim3(grid), dim3(NTHR), LDS_BYTES, stream, a); }
    }
}
```

```cpp
#include <hip/hip_runtime.h>
#include <cstdio>
#include <cstdint>

#ifndef MK_N_LAUNCHES
#define MK_N_LAUNCHES 1
#endif

constexpr int D = 1024, NB = 2, S = 8192, T = NB * S, DEPTH = 2;
constexpr int NH = 8, HD = 64, CHUNK = 128;
constexpr int IN_COLS = 2824;
constexpr int ZC = 3072, NQ = 0, NK = 512, NV = 1024, NGU = 1536, NGV = 1792, NCI = 2048, NCB = 2304, NCC = 2560, NF = 2816;
constexpr int PH = 8, NKEYS = 128, NEXP = 16384, TOPK = 16, DKEY = 256, DHALF = 128;
constexpr float EPS = 1e-6f;
constexpr int NTHR = 512, NWAVES = 8;

constexpr size_t MiB = 1u << 20;
constexpr size_t WS_CTL = 0, CTL_ZERO_BYTES = 96 * 1024;
constexpr size_t WS_F = 1 * MiB;
constexpr size_t WS_ZF = 1 * MiB + 512 * 1024;
constexpr size_t WS_EIDX = 2 * MiB;
constexpr size_t WS_GATE = 10 * MiB;
constexpr size_t WS_VN = 18 * MiB;
constexpr size_t WS_XN = 34 * MiB;
constexpr size_t WS_MIXN = 66 * MiB;
constexpr size_t WS_MIX = 98 * MiB;
constexpr size_t WS_XB = 162 * MiB;
constexpr size_t WS_ZB = 226 * MiB;
constexpr size_t WS_W = 322 * MiB;
constexpr size_t WS_EU = 346 * MiB;
constexpr size_t WS_EV = 378 * MiB;
constexpr size_t WS_XN8 = 412 * MiB;
constexpr size_t WS_SH = 430 * MiB;
constexpr size_t WS_SUK = 440 * MiB;
constexpr size_t WS_RSQ = 431 * MiB;
constexpr size_t WS_KN2 = 456 * MiB;
constexpr size_t WS_AI = 432 * MiB;
constexpr size_t WS_ES = 410 * MiB;
constexpr int NIN_PAD = 3072, WROWS_PER_LAYER = NIN_PAD + D + 2048;
constexpr size_t WS_END = 474 * MiB;
constexpr int CW_BAR = 4096;

constexpr int LDS_BYTES = 147456;
constexpr int MISC_OFF = 131072 + 320;

#define GAS __attribute__((address_space(1)))
#define LAS __attribute__((address_space(3)))
typedef GAS unsigned gu32;
#define RLX_AGENT __ATOMIC_RELAXED, __HIP_MEMORY_SCOPE_AGENT
constexpr int WTAB_OFF = MISC_OFF + 256;
__device__ __forceinline__ int tid_now() {
    const unsigned hw = (unsigned)__builtin_amdgcn_s_getreg((5 << 11) | 4) & 63u;
    const int w = __builtin_amdgcn_readfirstlane(((const volatile LAS int*)(unsigned)WTAB_OFF)[hw]);
    int lane; asm volatile("v_mbcnt_lo_u32_b32 %0, -1, 0\n\tv_mbcnt_hi_u32_b32 %0, -1, %0" : "=v"(lane));
    return w * 64 + lane;
}

#define XB_TMO      128
#define XB_XCNT(j)  (256  + 64 * (j))
#define XB_XSUB(j)  (1280 + 64 * (j))
#define XB_XGEN(j)  (2304 + 64 * (j))
#define XB_TOP      3328
#define XB_TOPGEN   3392
#define XCD_BAR_WORDS 3456
#define XB_SPIN_CAP (1u << 22)
__device__ __forceinline__ unsigned xb_ld(unsigned* p)              { return __hip_atomic_load(p, __ATOMIC_RELAXED, __HIP_MEMORY_SCOPE_AGENT); }
__device__ __forceinline__ unsigned xb_add(unsigned* p, unsigned v) { return __hip_atomic_fetch_add(p, v, __ATOMIC_RELAXED, __HIP_MEMORY_SCOPE_AGENT); }
__device__ __forceinline__ unsigned xb_xcc_id() { return (unsigned)__builtin_amdgcn_s_getreg((3 << 11) | 20) & 0xFu; }
#define XB_SPIN(cond, bar) do { unsigned _sp = 0; while (cond) { __builtin_amdgcn_s_sleep(1); \
    if ((++_sp & 255u) == 0u) { if (xb_ld(&(bar)[XB_TMO])) break; if (_sp > XB_SPIN_CAP) { atomicAdd(&(bar)[XB_TMO], 1u); break; } } } } while (0)
struct XcdBarrier { unsigned* bar; unsigned x; volatile LAS unsigned* st; };
__device__ __forceinline__ XcdBarrier xcd_barrier_post(unsigned* bar, volatile LAS unsigned* st) {
    XcdBarrier b; b.bar = bar; b.x = xb_xcc_id(); b.st = st;
    if (tid_now() == 0) (void)xb_add(&bar[XB_XCNT(b.x)], 1u);
    return b;
}
__device__ __forceinline__ void xcd_barrier_complete(unsigned* bar, unsigned x, unsigned& nloc, unsigned& nx) {
    const unsigned G = gridDim.x * gridDim.y * gridDim.z;
    unsigned sum, cnt, mine, sp = 0u;
    for (;;) {
        sum = 0u; cnt = 0u; mine = 0u;
#pragma unroll
        for (unsigned j = 0; j < 16; ++j) { const unsigned c = xb_ld(&bar[XB_XCNT(j)]); sum += c; cnt += (c > 0u) ? 1u : 0u; mine = (j == x) ? c : mine; }
        if (sum == G) break;
        __builtin_amdgcn_s_sleep(1);
        if ((++sp & 255u) == 0u) { if (xb_ld(&bar[XB_TMO])) break; if (sp > XB_SPIN_CAP) { atomicAdd(&bar[XB_TMO], 1u); break; } }
    }
    nloc = mine > 0u ? mine : 1u; nx = cnt > 0u ? cnt : 1u;
}
__device__ __forceinline__ void xcd_barrier(const XcdBarrier& b) {
    asm volatile("s_waitcnt vmcnt(0)" ::: "memory");
    __syncthreads();
    if (tid_now() == 0) {
        unsigned* bar = b.bar;
        __builtin_amdgcn_s_waitcnt(0);
        unsigned nloc = b.st[0], nx = b.st[1];
        if (nloc == 0u) { xcd_barrier_complete(bar, b.x, nloc, nx); b.st[0] = nloc; b.st[1] = nx; }
        const unsigned old = xb_add(&bar[XB_XSUB(b.x)], 1u);
        const unsigned gen = old / nloc;
        if (old + 1u == (gen + 1u) * nloc) {
            __builtin_amdgcn_fence(__ATOMIC_RELEASE, "agent");
            asm volatile("s_waitcnt vmcnt(0)" ::: "memory");
            const unsigned og = xb_add(&bar[XB_TOP], 1u);
            const unsigned tg = og / nx;
            if (og + 1u == (tg + 1u) * nx) xb_add(&bar[XB_TOPGEN], 1u);
            else XB_SPIN(xb_ld(&bar[XB_TOPGEN]) == tg, bar);
            __builtin_amdgcn_fence(__ATOMIC_ACQUIRE, "agent");
            xb_add(&bar[XB_XGEN(b.x)], 1u);
            asm volatile("s_waitcnt vmcnt(0)" ::: "memory");
        } else {
            XB_SPIN(xb_ld(&bar[XB_XGEN(b.x)]) == gen, bar);
            __builtin_amdgcn_fence(__ATOMIC_ACQUIRE, "agent");
            asm volatile("s_waitcnt vmcnt(0)" ::: "memory");
        }
    }
    __syncthreads();
}

namespace pg8 {
#define PG8_LAS __attribute__((address_space(3)))
typedef unsigned short bf16_t;
typedef short bf16x8 __attribute__((ext_vector_type(8)));
typedef float f32x4 __attribute__((ext_vector_type(4)));
typedef unsigned u32x4 __attribute__((ext_vector_type(4)));
constexpr int BM = 256, BK = 64, HALF = 128, HTB = HALF * BK * 2  , STAGE_BYTES = 8 * HTB, NXCD = 8, WGM = 8;

__host__ __device__ __forceinline__ int lds_byte(int r, int c) { const int st = (r >> 4) * 2 + (c >> 5), rr = r & 15, cc = c & 31, ob = rr * 64 + cc * 2; return st * 1024 + (ob ^ (((ob >> 9) & 1) << 5)); }
__host__ __device__ __forceinline__ void stage_rc(int b, int& R, int& C) { const int st = b / 1024, sb = b % 1024, swz = sb ^ (((sb >> 9) & 1) << 5); R = (st >> 1) * 16 + swz / 64; C = (st & 1) * 32 + (swz % 64) / 2; }
__host__ __device__ __forceinline__ int perm32(int rho) { const int n = rho >> 4, i = rho & 15; return 8 * (i >> 2) + 4 * n + (i & 3); }

struct Unit { int pm, pn; };
struct Gemm { const bf16_t* A; const bf16_t* Bt; int M, N, K; };

struct StaticOrder {
    int nM, nN, nwg, G, c;
    __host__ __device__ __forceinline__ void init(int M, int N, int G_, int c_) { nM = M / BM; nN = N / BM; nwg = nM * nN; G = G_; c = c_; }
    __host__ __device__ __forceinline__ bool next(int i, Unit& u) const {
        const long L = (long)i * G + c; if (L >= nwg) return false;
        int wgid = (int)L; { const int q = nwg / NXCD, r = nwg % NXCD, xcd = wgid % NXCD, off = wgid / NXCD; wgid = (xcd < r ? xcd * (q + 1) : r * (q + 1) + (xcd - r) * q) + off; }
        const int nig = WGM * nN, gid = wgid / nig, fm = gid * WGM, gsz = (nM - fm) < WGM ? (nM - fm) : WGM;
        u.pm = fm + ((wgid % nig) % gsz); u.pn = (wgid % nig) / gsz; return true;
    }
    __device__ __forceinline__ void a_ready(const Unit&) const {}
    __device__ __forceinline__ void done(const Unit&) const {}
};

__device__ __forceinline__ unsigned cvt_pk_bf16(float lo, float hi) { unsigned r; asm volatile("v_cvt_pk_bf16_f32 %0, %1, %2" : "=v"(r) : "v"(lo), "v"(hi)); return r; }
typedef float f32x2 __attribute__((ext_vector_type(2)));
__device__ __forceinline__ f32x2 gelu_pk(f32x2 v) {
    const f32x2 av = __builtin_elementwise_abs(v), d = av * 0.2316418882f + 1.0f;
    f32x2 t; t.x = __builtin_amdgcn_rcpf(d.x); t.y = __builtin_amdgcn_rcpf(d.y);
    f32x2 q = t * 0.5307027145f + (-0.7265760135f); q = q * t + 0.7107068705f; q = q * t + (-0.142248368f); q = q * t + 0.127414796f; q = q * t;
    const f32x2 s = (v * v) * (-0.72134752044f);
    f32x2 e; e.x = __builtin_amdgcn_exp2f(s.x); e.y = __builtin_amdgcn_exp2f(s.y);
    const f32x2 m = v * (q * e), r = v - m;
    f32x2 o; o.x = v.x < 0.f ? m.x : r.x; o.y = v.y < 0.f ? m.y : r.y; return o;
}

template <int ACT  > struct EpiBf16 {
    static constexpr bool PERM = true, AFTER_DRAIN = false; static constexpr int MIDK = 0; static_assert(ACT == 0 || ACT == 1, "EpiBf16: ACT is 0 (none) or 1 (gelu_pk)");
    bf16_t* O; int ldc; const float* bias; int split_cols; size_t split_stride; float scale0;
    __device__ __forceinline__ void operator()(const f32x4 (&acc)[2][2][4][2], const Unit& u, int wr, int wc, int fr, int fq) const {
        const int row0 = u.pm * BM + wr * 64 + fr; int colt = u.pn * BM; bf16_t* base = O;
        float sc = 1.f; if (split_cols) { const int t = colt / split_cols; base += (size_t)t * split_stride; colt -= t * split_cols; if (t == 0) sc = scale0; }
        const int col0 = colt + wc * 32 + 8 * fq, bcol0 = u.pn * BM + wc * 32 + 8 * fq;
        f32x4 bv[2][2];
#pragma unroll
        for (int bj = 0; bj < 2; ++bj)
#pragma unroll
            for (int n = 0; n < 2; ++n) bv[bj][n] = bias ? *(const f32x4*)(bias + bcol0 + bj * HALF + 4 * n) : (f32x4){0.f, 0.f, 0.f, 0.f};
#pragma unroll
        for (int ai = 0; ai < 2; ++ai)
#pragma unroll
            for (int m = 0; m < 4; ++m) { bf16_t* rowp = base + (size_t)(row0 + ai * HALF + m * 16) * ldc + col0;
#pragma unroll
                for (int bj = 0; bj < 2; ++bj) { f32x4 v0 = acc[ai][bj][m][0] + bv[bj][0], v1 = acc[ai][bj][m][1] + bv[bj][1];
                    if (ACT == 1) { f32x2 a = gelu_pk((f32x2){v0[0], v0[1]}), b = gelu_pk((f32x2){v0[2], v0[3]}), c = gelu_pk((f32x2){v1[0], v1[1]}), d = gelu_pk((f32x2){v1[2], v1[3]});
                        v0 = (f32x4){a.x, a.y, b.x, b.y}; v1 = (f32x4){c.x, c.y, d.x, d.y}; }
                    v0 = v0 * sc; v1 = v1 * sc; u32x4 w; w.x = cvt_pk_bf16(v0[0], v0[1]); w.y = cvt_pk_bf16(v0[2], v0[3]); w.z = cvt_pk_bf16(v1[0], v1[1]); w.w = cvt_pk_bf16(v1[2], v1[3]);
                    *(u32x4*)(rowp + bj * HALF) = w; } }
    }
};

struct PanelStats {
    unsigned* xbuf;
    unsigned* cnt;
    unsigned* tmo;
    int ntn; float eps;
    unsigned code;
    __device__ __forceinline__ bool run(const f32x4 (&v)[2][2][4][2], const Unit& u, int wr, int wc, int fr, int fq, PG8_LAS unsigned char* lds, int wid, int lane) const {
        typedef float f32x2v __attribute__((ext_vector_type(2)));
        PG8_LAS f32x2v* P = (PG8_LAS f32x2v*)lds;
        PG8_LAS f32x2v* S = (PG8_LAS f32x2v*)(lds + 8192);
        PG8_LAS unsigned* flag = (PG8_LAS unsigned*)(lds + 8192 + 2048);
#pragma unroll
        for (int ai = 0; ai < 2; ++ai)
#pragma unroll
            for (int m = 0; m < 4; ++m) {
                float s = 0.f;
#pragma unroll
                for (int bj = 0; bj < 2; ++bj)
#pragma unroll
                    for (int n = 0; n < 2; ++n) { const f32x4 x = v[ai][bj][m][n]; s += (x[0] + x[1]) + (x[2] + x[3]); }
                s += __shfl_xor(s, 16); s += __shfl_xor(s, 32);
                const float mw = s * (1.0f / 64.0f); float q = 0.f;
#pragma unroll
                for (int bj = 0; bj < 2; ++bj)
#pragma unroll
                    for (int n = 0; n < 2; ++n) { const f32x4 d = v[ai][bj][m][n] - mw; q += (d[0] * d[0] + d[1] * d[1]) + (d[2] * d[2] + d[3] * d[3]); }
                q += __shfl_xor(q, 16); q += __shfl_xor(q, 32);
                if (fq == 0) P[(ai * HALF + wr * 64 + m * 16 + fr) * 4 + wc] = (f32x2v){mw, q};
            }
        asm volatile("s_waitcnt lgkmcnt(0)" ::: "memory"); __builtin_amdgcn_s_barrier(); asm volatile("" ::: "memory");
#if defined(BROKEN_EXCHANGE_NO_WAIT)
#warning BROKEN CONTROL BUILD: the row-statistics exchange does not wait; results are wrong by design
        if (blockIdx.x >= 64) { const long long t0_ = clock64(); while (clock64() - t0_ < 60000) __builtin_amdgcn_s_sleep(8); }
#endif
        const int row = wid * 32 + (lane & 31);
        if (lane < 32) {
            const f32x2v a = P[row * 4 + 0], b = P[row * 4 + 1], c = P[row * 4 + 2], d = P[row * 4 + 3];
            const float mt = (a.x + b.x + c.x + d.x) * 0.25f;
            const float da = a.x - mt, db = b.x - mt, dc = c.x - mt, dd = d.x - mt;
            const float m2 = (a.y + b.y) + (c.y + d.y) + 64.0f * ((da * da + db * db) + (dc * dc + dd * dd));
            unsigned long long* slot = (unsigned long long*)xbuf + ((size_t)(u.pm * BM + row) * 4 + u.pn);
            __hip_atomic_store(slot, ((unsigned long long)__float_as_uint(m2) << 32) | __float_as_uint(mt), __ATOMIC_RELAXED, __HIP_MEMORY_SCOPE_AGENT);
        }
        asm volatile("s_waitcnt vmcnt(0)" ::: "memory");
        if (lane == 0) __hip_atomic_fetch_add(cnt + 64 * u.pm, 1u, __ATOMIC_RELAXED, __HIP_MEMORY_SCOPE_AGENT);
        if (wid == 0) {
            bool dead = false; const unsigned long long t0 = __builtin_amdgcn_s_memrealtime(); const unsigned want = 8u * (unsigned)ntn;
            for (;;) {
#if defined(BROKEN_EXCHANGE_NO_WAIT)
                break;
#endif
                if ((unsigned)__builtin_amdgcn_readfirstlane(__hip_atomic_load(cnt + 64 * u.pm, __ATOMIC_RELAXED, __HIP_MEMORY_SCOPE_AGENT)) >= want) break;
                if (__builtin_amdgcn_s_memrealtime() - t0 > 2000000ull) {
                    if (lane == 0) { unsigned expect = 0u; __hip_atomic_compare_exchange_strong(tmo + 1, &expect, code | (unsigned)(u.pm & 0xff), __ATOMIC_RELAXED, __ATOMIC_RELAXED, __HIP_MEMORY_SCOPE_AGENT);
                                     __hip_atomic_store(tmo, 1u, __ATOMIC_RELAXED, __HIP_MEMORY_SCOPE_AGENT); }
                    dead = true; break; }
                __builtin_amdgcn_s_sleep(2);
            }
            __builtin_amdgcn_fence(__ATOMIC_ACQUIRE, "agent");
            if (lane == 0) flag[0] = dead ? 1u : 0u;
        }
        asm volatile("s_waitcnt vmcnt(0) lgkmcnt(0)" ::: "memory"); __builtin_amdgcn_s_barrier(); asm volatile("" ::: "memory");
        const bool bad = flag[0] != 0u;
        if (lane < 32) {
            const unsigned long long* slot = (const unsigned long long*)xbuf + (size_t)(u.pm * BM + row) * 4; float mt[4], m2[4]; float ms = 0.f;
#pragma unroll
            for (int t = 0; t < 4; ++t) { if (t < ntn) { const unsigned long long w = __hip_atomic_load(slot + t, __ATOMIC_RELAXED, __HIP_MEMORY_SCOPE_AGENT); mt[t] = __uint_as_float((unsigned)w); m2[t] = __uint_as_float((unsigned)(w >> 32)); } else { mt[t] = 0.f; m2[t] = 0.f; } ms += mt[t]; }
            const float mean = ms / (float)ntn; float q = 0.f;
#pragma unroll
            for (int t = 0; t < 4; ++t) if (t < ntn) { const float dm = mt[t] - mean; q += m2[t] + 256.0f * dm * dm; }
            S[row] = (f32x2v){mean, 1.0f / sqrtf(q / (256.0f * (float)ntn) + eps)};
        }
        asm volatile("s_waitcnt lgkmcnt(0)" ::: "memory"); __builtin_amdgcn_s_barrier(); asm volatile("" ::: "memory");
        return bad;
    }
};
struct EpiLnRes {
    static constexpr bool PERM = false, AFTER_DRAIN = true;
    const float* base; float* out; int ldc; const float* bias; PanelStats st; unsigned poison;
    __device__ __forceinline__ void fused(f32x4 (&acc)[2][2][4][2], const Unit& u, int wr, int wc, int fr, int fq, PG8_LAS unsigned char* lds, int wid, int lane) const {
        typedef float f32x2v __attribute__((ext_vector_type(2)));
        const PG8_LAS f32x2v* S = (const PG8_LAS f32x2v*)(lds + 8192);
        const int col0 = u.pn * BM + wc * 32 + 4 * fq;
#pragma unroll
        for (int bj = 0; bj < 2; ++bj)
#pragma unroll
            for (int n = 0; n < 2; ++n) { const f32x4 bv = bias ? *(const f32x4*)(bias + col0 + bj * HALF + n * 16) : (f32x4){0.f, 0.f, 0.f, 0.f};
#pragma unroll
                for (int ai = 0; ai < 2; ++ai)
#pragma unroll
                    for (int m = 0; m < 4; ++m) acc[ai][bj][m][n] += bv; }
        f32x4 pre[4][2][2];
#pragma unroll
        for (int m = 0; m < 4; ++m) { const size_t off = (size_t)(u.pm * BM + wr * 64 + m * 16 + fr) * ldc + col0;
#pragma unroll
            for (int bj = 0; bj < 2; ++bj)
#pragma unroll
                for (int n = 0; n < 2; ++n) pre[m][bj][n] = *(const f32x4*)(base + off + bj * HALF + n * 16); }
        const bool bad = st.run(acc, u, wr, wc, fr, fq, lds, wid, lane) || poison != 0u;
        const float qnan = __builtin_nanf("");
#pragma unroll
        for (int ai = 0; ai < 2; ++ai)
#pragma unroll
            for (int m = 0; m < 4; ++m) { const int r = ai * HALF + wr * 64 + m * 16 + fr; const f32x2v sr = S[r]; const size_t off = (size_t)(u.pm * BM + r) * ldc + col0;
#pragma unroll
                for (int bj = 0; bj < 2; ++bj)
#pragma unroll
                    for (int n = 0; n < 2; ++n) { const f32x4 bs = ai == 0 ? pre[m][bj][n] : *(const f32x4*)(base + off + bj * HALF + n * 16); f32x4 o = bs + (acc[ai][bj][m][n] - sr.x) * sr.y;
                        if (bad) o = (f32x4){qnan, qnan, qnan, qnan}; *(f32x4*)(out + off + bj * HALF + n * 16) = o; }
                if (m & 1) asm volatile("" ::: "memory"); }
    }
};
struct EpiLnResLn {
    static constexpr bool PERM = false, AFTER_DRAIN = true;
    const float* base; float* out; bf16_t* xn; int ldc; const float* bias; PanelStats st1, st2; unsigned poison;
    __device__ __forceinline__ void fused(f32x4 (&acc)[2][2][4][2], const Unit& u, int wr, int wc, int fr, int fq, PG8_LAS unsigned char* lds, int wid, int lane) const {
        typedef float f32x2v __attribute__((ext_vector_type(2))); typedef unsigned u32x2v __attribute__((ext_vector_type(2)));
        const PG8_LAS f32x2v* S = (const PG8_LAS f32x2v*)(lds + 8192);
        const int col0 = u.pn * BM + wc * 32 + 4 * fq;
#pragma unroll
        for (int bj = 0; bj < 2; ++bj)
#pragma unroll
            for (int n = 0; n < 2; ++n) { const f32x4 bv = bias ? *(const f32x4*)(bias + col0 + bj * HALF + n * 16) : (f32x4){0.f, 0.f, 0.f, 0.f};
#pragma unroll
                for (int ai = 0; ai < 2; ++ai)
#pragma unroll
                    for (int m = 0; m < 4; ++m) acc[ai][bj][m][n] += bv; }
        bool bad = st1.run(acc, u, wr, wc, fr, fq, lds, wid, lane) || poison != 0u;
        const float qnan = __builtin_nanf("");
#pragma unroll
        for (int ai = 0; ai < 2; ++ai)
#pragma unroll
            for (int m = 0; m < 4; ++m) { const int r = ai * HALF + wr * 64 + m * 16 + fr; const f32x2v sr = S[r]; const size_t off = (size_t)(u.pm * BM + r) * ldc + col0;
#pragma unroll
                for (int bj = 0; bj < 2; ++bj)
#pragma unroll
                    for (int n = 0; n < 2; ++n) { const f32x4 bs = *(const f32x4*)(base + off + bj * HALF + n * 16); acc[ai][bj][m][n] = bs + (acc[ai][bj][m][n] - sr.x) * sr.y; }
                asm volatile("" : "+v"(acc[ai][0][m][0]), "+v"(acc[ai][0][m][1]), "+v"(acc[ai][1][m][0]), "+v"(acc[ai][1][m][1]));
                if (m & 1) asm volatile("" ::: "memory"); }
        const bool bad1 = bad;
        bad = st2.run(acc, u, wr, wc, fr, fq, lds, wid, lane) || bad;
#pragma unroll
        for (int ai = 0; ai < 2; ++ai)
#pragma unroll
            for (int m = 0; m < 4; ++m) { const int r = ai * HALF + wr * 64 + m * 16 + fr; const f32x2v sr = S[r]; const size_t off = (size_t)(u.pm * BM + r) * ldc + col0;
#pragma unroll
                for (int bj = 0; bj < 2; ++bj)
#pragma unroll
                    for (int n = 0; n < 2; ++n) { const f32x4 x1 = acc[ai][bj][m][n]; *(f32x4*)(out + off + bj * HALF + n * 16) = bad1 ? (f32x4){qnan, qnan, qnan, qnan} : x1;
                        const f32x4 o = (x1 - sr.x) * sr.y; u32x2v w; w.x = cvt_pk_bf16(o[0], o[1]); w.y = cvt_pk_bf16(o[2], o[3]);
                        if (bad) { w.x = 0x7fc07fc0u; w.y = 0x7fc07fc0u; } *(u32x2v*)(xn + off + bj * HALF + n * 16) = w; }
                asm volatile("" ::: "memory"); }
    }
};

template <class Epi, class Sched, bool ALIGN_EPI = false, bool SP2 = false>
__device__ __forceinline__ void gemm_phase(PG8_LAS unsigned char* lds, const Gemm g, const Sched& S, const Epi& E) {
    const int tid_ = tid_now();
    const int tid = tid_, wid = __builtin_amdgcn_readfirstlane(tid >> 6), lane = tid & 63, wr = wid >> 2, wc = wid & 3, fr = lane & 15, fq = lane >> 4;
    const int K = g.K, nt = K / BK;
    unsigned voffA[2], voffB[2];
#pragma unroll
    for (int i = 0; i < 2; ++i) { int R, C; stage_rc(tid * 16 + i * 8192, R, C); const int Rb = Epi::PERM ? ((R & ~31) + perm32(R & 31)) : R;
        voffA[i] = (unsigned)(R * K + C) * 2u; voffB[i] = (unsigned)(Rb * K + C) * 2u; }
    const size_t kstep = (size_t)(BK * 2);
    const size_t hstep = (size_t)HALF * K * 2;
    const size_t tstep = 2 * hstep;
    const unsigned ldsw = (unsigned)wid * 1024u;
    const int aoff = lds_byte(wr * 64 + fr, fq * 8), boff = lds_byte(wc * 32 + fr, fq * 8);
#define PG8_SA(b, h) (((b) * 2 + (h)) * HTB)
#define PG8_SB(b, h) ((4 + (b) * 2 + (h)) * HTB)
#define PG8_STAGE(bufoff, gbase, voff) do { _Pragma("unroll") for (int _i = 0; _i < 2; ++_i) \
        __builtin_amdgcn_global_load_lds((const unsigned*)((const char*)(gbase) + (voff)[_i]), (PG8_LAS unsigned*)(lds + (bufoff) + ldsw + _i * 8192), 16, 0, 0); } while (0)
#define PG8_LDA(dst, b, h) do { _Pragma("unroll") for (int m = 0; m < 4; ++m) _Pragma("unroll") for (int k = 0; k < 2; ++k) dst[m][k] = *(const PG8_LAS bf16x8*)(lds + PG8_SA(b, h) + aoff + m * 2048 + k * 1024); } while (0)
#define PG8_LDB(dst, b, h) do { _Pragma("unroll") for (int n = 0; n < 2; ++n) _Pragma("unroll") for (int k = 0; k < 2; ++k) dst[n][k] = *(const PG8_LAS bf16x8*)(lds + PG8_SB(b, h) + boff + n * 2048 + k * 1024); } while (0)
#define PG8_MMA(ai, bj, At, Bt) do { __builtin_amdgcn_s_setprio(1); _Pragma("unroll") for (int m = 0; m < 4; ++m) _Pragma("unroll") for (int n = 0; n < 2; ++n) _Pragma("unroll") for (int k = 0; k < 2; ++k) \
        acc[ai][bj][m][n] = __builtin_amdgcn_mfma_f32_16x16x32_bf16(Bt[n][k], At[m][k], acc[ai][bj][m][n], 0, 0, 0); __builtin_amdgcn_s_setprio(0); } while (0)
#define PG8_WAIT_V(n) asm volatile("s_waitcnt vmcnt(" #n ")" ::: "memory")
#define PG8_WAIT_L(n) asm volatile("s_waitcnt lgkmcnt(" #n ")" ::: "memory")
#define PG8_BAR __builtin_amdgcn_s_barrier()
#define PG8_SCHED __builtin_amdgcn_sched_barrier(0)
    Unit cur, nxt; int ui = 0;
    if (!S.next(0, cur)) return;
    f32x4 acc[2][2][4][2];
#pragma unroll
    for (int a = 0; a < 2; ++a)
#pragma unroll
        for (int b = 0; b < 2; ++b)
#pragma unroll
            for (int m = 0; m < 4; ++m)
#pragma unroll
                for (int n = 0; n < 2; ++n) acc[a][b][m][n] = (f32x4){0.f, 0.f, 0.f, 0.f};
    bf16x8 At[4][2], B0[2][2], B1[2][2];
    const char* cA = (const char*)g.A + (size_t)cur.pm * tstep; const char* cB = (const char*)g.Bt + (size_t)cur.pn * tstep;
    S.a_ready(cur);
    if constexpr (SP2) {
        PG8_STAGE(PG8_SB(0, 0), cB, voffB); PG8_STAGE(PG8_SB(0, 1), cB + hstep, voffB); PG8_STAGE(PG8_SA(0, 0), cA, voffA); PG8_STAGE(PG8_SA(0, 1), cA + hstep, voffA);
        if (wr == 1) PG8_BAR;
        PG8_WAIT_V(2); PG8_BAR;
        PG8_STAGE(PG8_SB(1, 0), cB + kstep, voffB); PG8_STAGE(PG8_SA(1, 0), cA + kstep, voffA); PG8_STAGE(PG8_SB(1, 1), cB + hstep + kstep, voffB);
        PG8_WAIT_V(6); PG8_BAR;
    } else {
        PG8_STAGE(PG8_SB(0, 0), cB, voffB); PG8_STAGE(PG8_SA(0, 0), cA, voffA); PG8_STAGE(PG8_SB(0, 1), cB + hstep, voffB); PG8_STAGE(PG8_SA(0, 1), cA + hstep, voffA);
        if (wr == 1) PG8_BAR;
        PG8_WAIT_V(4); PG8_BAR;
        PG8_STAGE(PG8_SB(1, 0), cB + kstep, voffB); PG8_STAGE(PG8_SA(1, 0), cA + kstep, voffA); PG8_STAGE(PG8_SB(1, 1), cB + hstep + kstep, voffB);
        PG8_WAIT_V(6); PG8_BAR;
    }
    for (;;) {
        const bool has_next = S.next(ui + 1, nxt);
        const char* nA = has_next ? (const char*)g.A + (size_t)nxt.pm * tstep : cA; const char* nB = has_next ? (const char*)g.Bt + (size_t)nxt.pn * tstep : cB;
        for (int t = 0; t < nt; t += 2) {
            const bool last = (t == nt - 2);
            const char* a1 = cA + (size_t)(t + 1) * kstep;
            const char* a2 = last ? nA : cA + (size_t)(t + 2) * kstep; const char* b2 = last ? nB : cB + (size_t)(t + 2) * kstep;
            const char* a3 = a2 + kstep; const char* b3 = b2 + kstep;
            if (last && has_next) S.a_ready(nxt);
            if constexpr (SP2) {
            PG8_LDB(B0, 0, 0); PG8_LDB(B1, 0, 1); PG8_SCHED; PG8_LDA(At, 0, 0); PG8_STAGE(PG8_SA(1, 1), a1 + hstep, voffA);
            PG8_WAIT_V(8); PG8_WAIT_L(0); PG8_BAR; PG8_MMA(0, 0, At, B0); PG8_MMA(0, 1, At, B1); PG8_BAR; PG8_SCHED;
            PG8_LDA(At, 0, 1); PG8_STAGE(PG8_SB(0, 0), b2, voffB); PG8_STAGE(PG8_SB(0, 1), b2 + hstep, voffB); PG8_STAGE(PG8_SA(0, 0), a2, voffA);
            PG8_WAIT_V(8); PG8_WAIT_L(0); PG8_BAR; PG8_MMA(1, 0, At, B0); PG8_MMA(1, 1, At, B1); PG8_BAR; PG8_SCHED;
            PG8_LDB(B0, 1, 0); PG8_LDB(B1, 1, 1); PG8_SCHED; PG8_LDA(At, 1, 0); PG8_STAGE(PG8_SA(0, 1), a2 + hstep, voffA);
            PG8_WAIT_V(8); PG8_WAIT_L(0); PG8_BAR; PG8_MMA(0, 0, At, B0); PG8_MMA(0, 1, At, B1); PG8_BAR; PG8_SCHED;
            PG8_LDA(At, 1, 1); PG8_STAGE(PG8_SB(1, 0), b3, voffB); PG8_STAGE(PG8_SB(1, 1), b3 + hstep, voffB); PG8_STAGE(PG8_SA(1, 0), a3, voffA);
            PG8_WAIT_V(8); PG8_WAIT_L(0); PG8_BAR; PG8_MMA(1, 0, At, B0); PG8_MMA(1, 1, At, B1); PG8_BAR; PG8_SCHED;
            } else {
            PG8_LDB(B0, 0, 0); PG8_SCHED; PG8_LDA(At, 0, 0); PG8_STAGE(PG8_SA(1, 1), a1 + hstep, voffA);
            PG8_WAIT_L(8); PG8_BAR; PG8_WAIT_L(0); PG8_MMA(0, 0, At, B0); PG8_BAR; PG8_SCHED;
            PG8_LDB(B1, 0, 1); PG8_STAGE(PG8_SB(0, 0), b2, voffB);
            PG8_BAR; PG8_WAIT_L(0); PG8_MMA(0, 1, At, B1); PG8_BAR;
            PG8_LDA(At, 0, 1); PG8_STAGE(PG8_SA(0, 0), a2, voffA);
            PG8_BAR; PG8_WAIT_L(0); PG8_MMA(1, 0, At, B0); PG8_BAR; PG8_SCHED;
            PG8_STAGE(PG8_SB(0, 1), b2 + hstep, voffB);
            PG8_WAIT_V(6); PG8_BAR; PG8_MMA(1, 1, At, B1); PG8_BAR;
            PG8_LDB(B0, 1, 0); PG8_SCHED; PG8_LDA(At, 1, 0); PG8_STAGE(PG8_SA(0, 1), a2 + hstep, voffA);
            PG8_WAIT_L(8); PG8_BAR; PG8_WAIT_L(0); PG8_MMA(0, 0, At, B0); PG8_BAR; PG8_SCHED;
            PG8_LDB(B1, 1, 1); PG8_STAGE(PG8_SB(1, 0), b3, voffB);
            PG8_BAR; PG8_WAIT_L(0); PG8_MMA(0, 1, At, B1); PG8_BAR;
            PG8_LDA(At, 1, 1); PG8_STAGE(PG8_SA(1, 0), a3, voffA);
            PG8_BAR; PG8_WAIT_L(0); PG8_MMA(1, 0, At, B0); PG8_BAR; PG8_SCHED;
            PG8_STAGE(PG8_SB(1, 1), b3 + hstep, voffB);
            PG8_WAIT_V(6); PG8_BAR; PG8_MMA(1, 1, At, B1); PG8_BAR;
            }
            if constexpr (Epi::MIDK > 0) { if (t + 2 == Epi::MIDK) E.midscale(acc, cur, wr, fr); }
        }
        if constexpr (ALIGN_EPI) { if (wr == 0) PG8_BAR; }
        if constexpr (!Epi::AFTER_DRAIN) { E(acc, cur, wr, wc, fr, fq); S.done(cur); }
        if (!has_next) break;
#pragma unroll
        for (int a = 0; a < 2; ++a)
#pragma unroll
            for (int b = 0; b < 2; ++b)
#pragma unroll
                for (int m = 0; m < 4; ++m)
#pragma unroll
                    for (int n = 0; n < 2; ++n) acc[a][b][m][n] = (f32x4){0.f, 0.f, 0.f, 0.f};
        cur = nxt; cA = nA; cB = nB; ++ui;
        if constexpr (ALIGN_EPI) { if (wr == 1) PG8_BAR; }
    }
    PG8_WAIT_V(0);
    if constexpr (!ALIGN_EPI) { if (wr == 0) PG8_BAR; }
    PG8_BAR;
    if constexpr (Epi::AFTER_DRAIN) { E.fused(acc, cur, wr, wc, fr, fq, lds, wid, lane); S.done(cur); }
#undef PG8_SA
#undef PG8_SB
#undef PG8_STAGE
#undef PG8_LDA
#undef PG8_LDB
#undef PG8_MMA
#undef PG8_WAIT_V
#undef PG8_WAIT_L
#undef PG8_BAR
#undef PG8_SCHED
}
}

#ifndef PG8_SP2
#define PG8_SP2 true
#endif
#ifndef PG8_ALIGN
#define PG8_ALIGN true
#endif

typedef unsigned short bf16;
typedef float pk_f32x2 __attribute__((ext_vector_type(2))); typedef __bf16 pk_bf16x2 __attribute__((ext_vector_type(2)));
__device__ __forceinline__ unsigned pk2(float lo, float hi) { pk_f32x2 v = {lo, hi}; pk_bf16x2 b = __builtin_convertvector(v, pk_bf16x2); return __builtin_bit_cast(unsigned, b); }
__device__ __forceinline__ unsigned f2bf(float f) { return pk2(f, 0.f) & 0xffffu; }
__device__ __forceinline__ unsigned pack4_i8(float a, float b, float c, float d, float inv) {
    const unsigned fa = __float_as_uint(__builtin_fmaf(a, inv, 12582912.f)), fb = __float_as_uint(__builtin_fmaf(b, inv, 12582912.f));
    const unsigned fc = __float_as_uint(__builtin_fmaf(c, inv, 12582912.f)), fd = __float_as_uint(__builtin_fmaf(d, inv, 12582912.f));
    return __builtin_amdgcn_perm(fb, fa, 0x0c0c0400u) | __builtin_amdgcn_perm(fd, fc, 0x04000c0cu);
}
__device__ __forceinline__ float bf_lo(unsigned u) { return __builtin_bit_cast(float, u << 16); }
__device__ __forceinline__ float bf_hi(unsigned u) { return __builtin_bit_cast(float, u & 0xffff0000u); }

struct EpiZ {
    static constexpr bool PERM = true, AFTER_DRAIN = false; static constexpr int MIDK = 0;
    bf16* ZB; float* ZF; float qscale; unsigned long long* KN2;
    __device__ __forceinline__ void operator()(const pg8::f32x4 (&acc)[2][2][4][2], const pg8::Unit& u, int wr, int wc, int fr, int fq) const {
        if (u.pn == 11) {
            if (wc == 0 && fq == 0) {
#pragma unroll
                for (int ai = 0; ai < 2; ++ai)
#pragma unroll
                    for (int m = 0; m < 4; ++m) { const int row = u.pm * 256 + ai * 128 + wr * 64 + m * 16 + fr; float* zp = ZF + (size_t)(row >> 13) * NH * S + (row & (S - 1));
#pragma unroll
                        for (int n = 0; n < 2; ++n)
#pragma unroll
                            for (int j = 0; j < 4; ++j) zp[(size_t)(4 * n + j) * S] = acc[ai][0][m][n][j]; }
            }
            return;
        }
        const float sc = (u.pn < 2) ? qscale : 1.f;
#pragma unroll
        for (int ai = 0; ai < 2; ++ai)
#pragma unroll
            for (int m = 0; m < 4; ++m) { bf16* rowp = ZB + (size_t)(u.pm * 256 + ai * 128 + wr * 64 + m * 16 + fr) * ZC + u.pn * 256 + wc * 32 + 8 * fq;
#pragma unroll
                for (int bj = 0; bj < 2; ++bj) { const pg8::f32x4 v0 = acc[ai][bj][m][0] * sc, v1 = acc[ai][bj][m][1] * sc;
                    pg8::u32x4 w; w.x = pg8::cvt_pk_bf16(v0[0], v0[1]); w.y = pg8::cvt_pk_bf16(v0[2], v0[3]); w.z = pg8::cvt_pk_bf16(v1[0], v1[1]); w.w = pg8::cvt_pk_bf16(v1[2], v1[3]);
                    *(pg8::u32x4*)(rowp + bj * 128) = w;
                    if (u.pn == 2 || u.pn == 3) {
                        float sq = 0.f;
#pragma unroll
                        for (int j = 0; j < 4; ++j) { const float lo_ = __uint_as_float(w[j] << 16), hi_ = __uint_as_float(w[j] & 0xffff0000u); sq += lo_ * lo_ + hi_ * hi_; }
                        sq += __shfl_xor(sq, 16); sq += __shfl_xor(sq, 32);
                        const int row = u.pm * 256 + ai * 128 + wr * 64 + m * 16 + fr, hd = (u.pn - 2) * 4 + 2 * bj + (wc >> 1);
                        if (fq == 0) atomicAdd(KN2 + ((size_t)((row >> 13) * NH + hd) * S + (row & (S - 1))), (unsigned long long)(sq * 1048576.f));
                    } } }
    }
};

struct EpiOut {
    static constexpr bool PERM = false, AFTER_DRAIN = false; static constexpr int MIDK = 8;
    bf16* C; int ldc; const void* R; int r_bf16; const unsigned long long* rsq;
    __device__ __forceinline__ void midscale(pg8::f32x4 (&acc)[2][2][4][2], const pg8::Unit& u, int wr, int fr) const {
#pragma unroll
        for (int ai = 0; ai < 2; ++ai)
#pragma unroll
            for (int m = 0; m < 4; ++m) { const float sc = rsqrtf((float)rsq[u.pm * 256 + ai * 128 + wr * 64 + m * 16 + fr] * (1.f / (512.f * 16777216.f)) + 1e-6f);
#pragma unroll
                for (int bj = 0; bj < 2; ++bj)
#pragma unroll
                    for (int n = 0; n < 2; ++n) acc[ai][bj][m][n] *= sc; }
    }
    __device__ __forceinline__ void operator()(const pg8::f32x4 (&acc)[2][2][4][2], const pg8::Unit& u, int wr, int wc, int fr, int fq) const {
#pragma unroll
        for (int ai = 0; ai < 2; ++ai)
#pragma unroll
            for (int m = 0; m < 4; ++m) {
                const size_t roff = (size_t)(u.pm * 256 + ai * 128 + wr * 64 + m * 16 + fr) * ldc;
#pragma unroll
                for (int bj = 0; bj < 2; ++bj)
#pragma unroll
                    for (int n = 0; n < 2; ++n) { const int col = u.pn * 256 + bj * 128 + wc * 32 + n * 16 + 4 * fq;
                        pg8::f32x4 rv;
                        if (r_bf16) { const uint2 rb = *(const uint2*)((const bf16*)R + roff + col); rv = (pg8::f32x4){bf_lo(rb.x), bf_hi(rb.x), bf_lo(rb.y), bf_hi(rb.y)}; }
                        else rv = *(const pg8::f32x4*)((const float*)R + roff + col);
                        const pg8::f32x4 o_ = acc[ai][bj][m][n] + rv;
                        *(uint2*)(C + roff + col) = make_uint2(pk2(o_[0], o_[1]), pk2(o_[2], o_[3])); }
            }
    }
};

#include <hip/hip_bf16.h>
#include <cmath>
template <bool REMAP> __device__ __forceinline__ void p0_transpose_item(const float* W, int K, int N, bf16* WT, LAS float* scr, int item, int lane, int nblk, const float* kscale = nullptr, int kscale_n = 0) {
    const int kb = item / nblk, nb = item % nblk, k0 = 64 * kb, n0 = 32 * nb;
    const int ncol = n0 + (lane & 31);
    float wl[32];
#pragma unroll
    for (int i = 0; i < 32; ++i) { const int kk = 2 * i + (lane >> 5); wl[i] = (ncol < N) ? W[(size_t)(k0 + kk) * N + ncol] : 0.f; }
#pragma unroll
    for (int i = 0; i < 32; ++i) { const int kk = 2 * i + (lane >> 5); float wv_ = wl[i];
        if (kscale && k0 + kk < kscale_n) wv_ *= kscale[k0 + kk];
        scr[kk * 33 + (lane & 31)] = wv_; }
    asm volatile("s_waitcnt lgkmcnt(0)" ::: "memory");
    const int ch = lane & 7;
#pragma unroll
    for (int j = 0; j < 4; ++j) { const int n = (lane >> 3) + 8 * j; const LAS float* sp = scr + (8 * ch) * 33 + n;
        uint4 o; o.x = pk2(sp[0 * 33], sp[1 * 33]); o.y = pk2(sp[2 * 33], sp[3 * 33]); o.z = pk2(sp[4 * 33], sp[5 * 33]); o.w = pk2(sp[6 * 33], sp[7 * 33]);
        int drow = n0 + n;
        if (REMAP) { if (drow >= 1536 && drow < 1544) drow += NF - 1536; else if (drow >= 1544 && drow < IN_COLS) drow -= 8; }
        *(uint4*)(WT + (size_t)drow * K + k0 + 8 * ch) = o; }
    asm volatile("s_waitcnt lgkmcnt(0)" ::: "memory");
}
constexpr int WI_IN = 16 * (NIN_PAD / 32), WI_OUT = 16 * (D / 32), WI_Q = 16 * (2048 / 32), WI_L = WI_IN + WI_OUT + WI_Q;
struct WeightJob { const float* w_in; const float* w_out; const float* w_query; const float* gmix; bf16* WT; int it0, it1; };
__device__ __forceinline__ void weight_item(const WeightJob& W, int it, LAS float* scr, int lane) {
    const int l = it / WI_L; int r = it % WI_L;
    bf16* base = W.WT + (size_t)l * WROWS_PER_LAYER * D;
    if (r < WI_IN) { p0_transpose_item<true>(W.w_in + (size_t)l * D * IN_COLS, D, IN_COLS, base, scr, r, lane, NIN_PAD / 32); return; } r -= WI_IN;
    if (r < WI_OUT) { p0_transpose_item<false>(W.w_out + (size_t)l * D * D, D, D, base + (size_t)NIN_PAD * D, scr, r, lane, D / 32, W.gmix + (size_t)l * D, 512); return; } r -= WI_OUT;
    p0_transpose_item<false>(W.w_query + (size_t)l * D * 2048, D, 2048, base + (size_t)(NIN_PAD + D) * D, scr, r, lane, 2048 / 32);
}
__device__ __forceinline__ LAS float* weight_scr(LAS unsigned char* lds, int wave) { return (LAS float*)(lds + wave * 16384 + 1024); }
__device__ __forceinline__ int weight_units(const WeightJob& W) { return (W.it1 - W.it0 + 31) / 32; }
__device__ __forceinline__ void weight_unit(const WeightJob& W, int wu, LAS unsigned char* lds, int wave, int lane) {
    LAS float* scr = weight_scr(lds, wave);
#pragma unroll 1
    for (int k = 0; k < 4; ++k) { const int it = W.it0 + 32 * wu + wave + 8 * k; if (it < W.it1) weight_item(W, it, scr, lane); }
}
struct QuantJob { const float* eu; const float* ev; unsigned char* EU; unsigned char* EV; float* ES; int l; };
constexpr int QUANT_UNITS = 2 * NEXP / 128;
__device__ __forceinline__ float wave_max63(float v) {
    v = fmaxf(v, __builtin_bit_cast(float, __builtin_amdgcn_update_dpp(0, __builtin_bit_cast(int, v), 0xB1, 0xF, 0xF, false)));
    v = fmaxf(v, __builtin_bit_cast(float, __builtin_amdgcn_update_dpp(0, __builtin_bit_cast(int, v), 0x4E, 0xF, 0xF, false)));
    v = fmaxf(v, __builtin_bit_cast(float, __builtin_amdgcn_update_dpp(0, __builtin_bit_cast(int, v), 0x141, 0xF, 0xF, false)));
    v = fmaxf(v, __builtin_bit_cast(float, __builtin_amdgcn_update_dpp(0, __builtin_bit_cast(int, v), 0x140, 0xF, 0xF, false)));
    v = fmaxf(v, __builtin_bit_cast(float, __builtin_amdgcn_update_dpp(0, __builtin_bit_cast(int, v), 0x142, 0xA, 0xF, false)));
    v = fmaxf(v, __builtin_bit_cast(float, __builtin_amdgcn_update_dpp(0, __builtin_bit_cast(int, v), 0x143, 0xC, 0xF, false)));
    return __builtin_bit_cast(float, __builtin_amdgcn_readlane(__builtin_bit_cast(int, v), 63));
}
__device__ __forceinline__ void quant_unit(const QuantJob& J, int qu, int wave, int lane) {
    const int tbl = qu / (NEXP / 128), e0 = (qu % (NEXP / 128)) * 128 + wave * 16;
    const float* srcb = (tbl ? J.ev : J.eu) + ((size_t)J.l * NEXP + e0) * D;
    unsigned char* dstb = (tbl ? J.EV : J.EU) + (size_t)J.l * NEXP * D + ((size_t)(lane >> 3) * NEXP + e0) * 128 + 16 * (lane & 7);
    float* esb = J.ES + (size_t)tbl * (DEPTH * NEXP) + (size_t)J.l * NEXP + e0;
    const float qmax = tbl ? 448.f : 127.f;
#pragma unroll 1
    for (int g = 0; g < 16; g += 4) {
        float4 x[4][4];
#pragma unroll
        for (int k = 0; k < 4; ++k)
#pragma unroll
            for (int j = 0; j < 4; ++j) x[k][j] = ((const float4*)(srcb + (size_t)(g + k) * D))[4 * lane + j];
#pragma unroll
        for (int k = 0; k < 4; ++k) {
            float am = 0.f;
#pragma unroll
            for (int j = 0; j < 4; ++j) am = fmaxf(am, fmaxf(fmaxf(fabsf(x[k][j].x), fabsf(x[k][j].y)), fmaxf(fabsf(x[k][j].z), fabsf(x[k][j].w))));
            am = wave_max63(am);
            const float inv = am > 0.f ? qmax / am : 0.f;
            unsigned pk[4];
#pragma unroll
            for (int j = 0; j < 4; ++j) {
                if (tbl) { int w = __builtin_amdgcn_cvt_pk_fp8_f32(x[k][j].x * inv, x[k][j].y * inv, 0, false); w = __builtin_amdgcn_cvt_pk_fp8_f32(x[k][j].z * inv, x[k][j].w * inv, w, true); pk[j] = (unsigned)w; }
                else pk[j] = pack4_i8(x[k][j].x, x[k][j].y, x[k][j].z, x[k][j].w, inv); }
            *(uint4*)(dstb + (size_t)(g + k) * 128) = make_uint4(pk[0], pk[1], pk[2], pk[3]);
            if (lane == 0) esb[g + k] = am / qmax;
        }
    }
}
namespace attn_body {
using bf16=__hip_bfloat16;
using bf16x8=__attribute__((ext_vector_type(8)))short;
using s16x4=__attribute__((ext_vector_type(4)))short;
using f32x16=__attribute__((ext_vector_type(16)))float;
using u32x4=__attribute__((ext_vector_type(4)))unsigned;
constexpr int BATCH=2,NHEAD=8,SEQ=8192,D=64,IP=3072,OP=1024;
constexpr float SKIP_L2=40.f;
constexpr int NW=8,QBLK=32,QB=QBLK*NW,KVBLK=64,NQB=SEQ/QB;
constexpr int ATTN_UNIT_ROWS=QB;
__device__ __forceinline__ int crow(int r,int hi){return (r&3)+8*(r>>2)+4*hi;}
#define SBAR() __builtin_amdgcn_sched_barrier(0)
__device__ __forceinline__ void cmask(f32x16&p0,f32x16&p1,int jb,int qrel,int hi){
  const float NEG=-INFINITY; int kb=64*jb+4*hi;
  #pragma unroll
  for(int r=0;r<16;++r){int kv=kb+(r&3)+8*(r>>2); if(kv>qrel)p0[r]=NEG; if(kv+32>qrel)p1[r]=NEG;}
}

constexpr int NSLOT=3, SLOTB=8192;
constexpr int LDS_K=0, LDS_V=NSLOT*SLOTB, LDS_WS=2*NSLOT*SLOTB, LDS_OST=LDS_WS+NW*64*4, LDS_G=LDS_OST+NW*4096, LDS_BYTES=LDS_G+SEQ*4;
constexpr float C2=0.125f*1.4426950408889634f;
__device__ __forceinline__ void glds16(const void*gsrc,unsigned lds_dst){unsigned keep;
  asm volatile("s_mov_b32 %0, m0\n\ts_mov_b32 m0, %2\n\ts_nop 0\n\tglobal_load_lds_dwordx4 %1, off\n\ts_mov_b32 m0, %0":"=&s"(keep):"v"(gsrc),"s"(lds_dst):"memory");}
__device__ __forceinline__ float max3f(float a,float b,float c){float r;asm("v_max3_f32 %0, %1, %2, %3":"=v"(r):"v"(a),"v"(b),"v"(c));return r;}
__device__ __forceinline__ float max2f(float a,float b){float r;asm("v_max_f32_e32 %0, %1, %2":"=v"(r):"v"(a),"v"(b));return r;}
__device__ __forceinline__ float fadd_s(float a,float b){float r;asm("v_add_f32_e32 %0, %1, %2":"=v"(r):"v"(a),"v"(b));return r;}
__device__ __forceinline__ float fsub_s(float a,float b){float r;asm("v_sub_f32_e32 %0, %1, %2":"=v"(r):"v"(a),"v"(b));return r;}
typedef float f32x2_t __attribute__((ext_vector_type(2))); typedef __bf16 bf16x2_t __attribute__((ext_vector_type(2)));
__device__ __forceinline__ unsigned cvtpk_s(float lo,float hi){f32x2_t v={lo,hi};bf16x2_t b=__builtin_convertvector(v,bf16x2_t);return __builtin_bit_cast(unsigned,b);}
#define WAIT_BAR(N) asm volatile("s_waitcnt vmcnt(" #N ") lgkmcnt(0)\n\ts_barrier":::"memory")

__device__ __forceinline__ void qkt(f32x16&p0,f32x16&p1,const char*Kslot,const bf16x8*qr,int r32,int hi){
  const char*kb=Kslot+hi*1024+r32*16;
  #pragma unroll
  for(int d0=0;d0<4;++d0){
    const bf16x8 b0=*reinterpret_cast<const bf16x8*>(kb+d0*2048);
    const bf16x8 b1=*reinterpret_cast<const bf16x8*>(kb+d0*2048+512);
    p0=__builtin_amdgcn_mfma_f32_32x32x16_bf16(b0,qr[d0],p0,0,0,0);p1=__builtin_amdgcn_mfma_f32_32x32x16_bf16(b1,qr[d0],p1,0,0,0);}
}
typedef __attribute__((address_space(3))) const char* lds_cptr;
typedef short v4i16_t __attribute__((ext_vector_type(4)));
__device__ __forceinline__ void kload8(bf16x8*kf,lds_cptr kp){
  kf[0]=*(const __attribute__((address_space(3))) bf16x8*)(kp);      kf[1]=*(const __attribute__((address_space(3))) bf16x8*)(kp+512);
  kf[2]=*(const __attribute__((address_space(3))) bf16x8*)(kp+2048); kf[3]=*(const __attribute__((address_space(3))) bf16x8*)(kp+2560);
  kf[4]=*(const __attribute__((address_space(3))) bf16x8*)(kp+4096); kf[5]=*(const __attribute__((address_space(3))) bf16x8*)(kp+4608);
  kf[6]=*(const __attribute__((address_space(3))) bf16x8*)(kp+6144); kf[7]=*(const __attribute__((address_space(3))) bf16x8*)(kp+6656);
}
__device__ __forceinline__ void kload2(bf16x8*kf,lds_cptr kp,int j){ kf[2*j]=*(const __attribute__((address_space(3))) bf16x8*)(kp+j*2048); kf[2*j+1]=*(const __attribute__((address_space(3))) bf16x8*)(kp+j*2048+512); }
__device__ __forceinline__ s16x4 vtr(lds_cptr p){ return __builtin_bit_cast(s16x4,__builtin_amdgcn_ds_read_tr16_b64_v4i16((__attribute__((address_space(3))) v4i16_t*)p)); }
__device__ __forceinline__ float rowmax(const f32x16&p0,const f32x16&p1){
  float a=max3f(p0[0],p0[1],p1[0]),b=max3f(p0[2],p0[3],p1[1]);a=max3f(a,p1[2],p1[3]);
  #pragma unroll
  for(int r=4;r<16;r+=4){a=max3f(a,p0[r],p0[r+1]);b=max3f(b,p0[r+2],p0[r+3]);a=max3f(a,p1[r],p1[r+1]);b=max3f(b,p1[r+2],p1[r+3]);}
  const float m=max2f(a,b);
  auto rr=__builtin_amdgcn_permlane32_swap(__float_as_uint(m),__float_as_uint(m),false,false);
  return max2f(__uint_as_float(rr[0]),__uint_as_float(rr[1]));
}
__device__ __forceinline__ void pv(f32x16*o,int vb,bf16x8 pa0,bf16x8 pa1,bf16x8 pa2,bf16x8 pa3){
  #pragma unroll
  for(int d0=0;d0<2;++d0){s16x4 lo[4],hi[4];
    #pragma unroll
    for(int ks=0;ks<4;++ks){
      asm volatile("ds_read_b64_tr_b16 %0,%1 offset:%c2":"=&v"(lo[ks]):"v"(vb),"i"(d0*4096+ks*1024):"memory");
      asm volatile("ds_read_b64_tr_b16 %0,%1 offset:%c2":"=&v"(hi[ks]):"v"(vb),"i"(d0*4096+ks*1024+512):"memory");}
    asm volatile("s_waitcnt lgkmcnt(0)":::"memory");SBAR();
    #define PK(k) (bf16x8){lo[k][0],lo[k][1],lo[k][2],lo[k][3],hi[k][0],hi[k][1],hi[k][2],hi[k][3]}
    o[d0]=__builtin_amdgcn_mfma_f32_32x32x16_bf16(pa0,PK(0),o[d0],0,0,0);
    o[d0]=__builtin_amdgcn_mfma_f32_32x32x16_bf16(pa1,PK(1),o[d0],0,0,0);
    o[d0]=__builtin_amdgcn_mfma_f32_32x32x16_bf16(pa2,PK(2),o[d0],0,0,0);
    o[d0]=__builtin_amdgcn_mfma_f32_32x32x16_bf16(pa3,PK(3),o[d0],0,0,0);
    #undef PK
  }
}

#ifndef ATTN_STORE16
#define ATTN_STORE16(p,v) (*(u32x4*)(p)=(v))
#endif
template<int THRL> __device__ __forceinline__ void attn_unit(int b,int h,int qb,const bf16*Q,const bf16*K,const bf16*V,bf16*O,const float*ZFt,float fbias,unsigned long long*RSQ,const unsigned long long*KN2,char*shm){
  const int tid_=tid_now();
  const int tid=tid_,lane=tid&63,r32=lane&31,hi=lane>>5; const int wid=__builtin_amdgcn_readfirstlane(tid>>6);
  const long rowbase=(long)b*SEQ; const int q0=qb*QB;
  const bf16*Qw=Q+(rowbase+q0+wid*QBLK)*IP+h*D;
  const bf16*Kh0=K+rowbase*IP+h*D,*Vh0=V+rowbase*IP+h*D;
  typedef float f32x4v __attribute__((ext_vector_type(4)));
  { const int n=q0+QB; __attribute__((address_space(3))) float*gl=(__attribute__((address_space(3))) float*)(shm+LDS_G);
    __attribute__((address_space(3))) float*wsum=(__attribute__((address_space(3))) float*)(shm+LDS_WS);
    float loc[16]; float run=0.f; const bool act=(16*tid<n);
    if(act){ const f32x4v*zs=(const f32x4v*)(ZFt+((long)b*NHEAD+h)*SEQ+16*tid);
      #pragma unroll
      for(int j4=0;j4<4;++j4){ const f32x4v z=zs[j4];
        #pragma unroll
        for(int j=0;j<4;++j){ const float x=z[j]+fbias; const float ls=fminf(x,0.f)-__logf(1.f+__expf(-fabsf(x))); run+=ls*1.4426950408889634f; loc[4*j4+j]=run; } } }
    float inc=run;
    #pragma unroll
    for(int o_=1;o_<64;o_<<=1){ const float t_=__shfl_up(inc,o_); if(lane>=o_)inc+=t_; }
    if(lane==63)wsum[wid]=inc;
    __syncthreads();
    float base=inc-run;
    for(int w_=0;w_<wid;++w_)base+=wsum[w_];
    if(act){
      #pragma unroll
      for(int j4=0;j4<4;++j4)*(__attribute__((address_space(3))) f32x4v*)(gl+16*tid+4*j4)=(f32x4v){loc[4*j4]+base,loc[4*j4+1]+base,loc[4*j4+2]+base,loc[4*j4+3]+base}; }
    __syncthreads(); }
  const float Gq=((const __attribute__((address_space(3))) float*)(shm+LDS_G))[q0+wid*QBLK+r32];
  bf16x8 qr[4];
  #pragma unroll
  for(int d0=0;d0<4;++d0)qr[d0]=*reinterpret_cast<const bf16x8*>(&Qw[(long)r32*IP+d0*16+hi*8]);
  int j0=0;
  { __attribute__((address_space(3))) float*red=(__attribute__((address_space(3))) float*)(shm+LDS_WS);
    const __attribute__((address_space(3))) float*glf=(const __attribute__((address_space(3))) float*)(shm+LDS_G);
    const int n=q0+QB; float km=0.f; const unsigned long long*kn=KN2+((long)b*NHEAD+h)*SEQ;
    { unsigned long long kv[16];
      #pragma unroll
      for(int k_=0;k_<16;++k_){const int i=tid+k_*NW*64; kv[k_]=(i<n)?kn[i]:0ull;}
      #pragma unroll
      for(int k_=0;k_<16;++k_)km=fmaxf(km,(float)kv[k_]); }
    float qs=0.f;
    #pragma unroll
    for(int d0=0;d0<4;++d0){
      #pragma unroll
      for(int j=0;j<8;++j){const float v=__uint_as_float((unsigned)(unsigned short)qr[d0][j]<<16);qs+=v*v;}}
    {auto rr=__builtin_amdgcn_permlane32_swap(__float_as_uint(qs),__float_as_uint(qs),false,false);qs=__uint_as_float(rr[0])+__uint_as_float(rr[1]);}
    float sd=0.f;
    { const bf16*Kd=Kh0+(long)(q0+wid*QBLK+r32)*IP+hi*8;
      #pragma unroll
      for(int d0=0;d0<4;++d0){ const bf16x8 kd=*reinterpret_cast<const bf16x8*>(&Kd[d0*16]);
        #pragma unroll
        for(int j=0;j<8;++j)sd+=__uint_as_float((unsigned)(unsigned short)qr[d0][j]<<16)*__uint_as_float((unsigned)(unsigned short)kd[j]<<16); } }
    {auto rr=__builtin_amdgcn_permlane32_swap(__float_as_uint(sd),__float_as_uint(sd),false,false);sd=__uint_as_float(rr[0])+__uint_as_float(rr[1]);}
    #pragma unroll
    for(int o_=1;o_<64;o_<<=1){km=fmaxf(km,__shfl_xor(km,o_));qs=fmaxf(qs,__shfl_xor(qs,o_));sd=fminf(sd,__shfl_xor(sd,o_));}
    if(lane==0){red[wid]=km;red[8+wid]=qs;red[32+wid]=sd;}
    __syncthreads();
    if(tid==0){ float k2=0.f,q2=0.f,sm=0.f;
      for(int w_=0;w_<NW;++w_){k2=fmaxf(k2,red[w_]);q2=fmaxf(q2,red[8+w_]);sm=fminf(sm,red[32+w_]);}
      const float S2=sqrtf(k2*(1.f/1048576.f)*q2)*1.02f, lowm=fmaxf(sm*1.02f-0.05f,-S2), thr=-(SKIP_L2+S2-lowm), g0=glf[q0];
      int lo=0,hiT=n/KVBLK-4;
      while(lo<hiT){const int mid=(lo+hiT)>>1; if(g0-glf[64*mid+63]<thr)lo=mid+1; else hiT=mid;}
      ((__attribute__((address_space(3))) int*)red)[16]=lo&~1; }
    __syncthreads();
    j0=__builtin_amdgcn_readfirstlane(((const __attribute__((address_space(3))) int*)red)[16]);
    __syncthreads(); }
  const bf16*Kh=Kh0+(long)j0*KVBLK*IP,*Vh=Vh0+(long)j0*KVBLK*IP;
  typedef __attribute__((address_space(3))) const f32x4v* lds_f4p;
  const lds_f4p gl0=(lds_f4p)(shm+LDS_G)+hi+16*j0;
  const unsigned lds0=(unsigned)(uintptr_t)shm;
  float*wsf=(float*)(shm+LDS_WS)+wid*64;
  const bf16*ksrc=Kh+(long)lane*IP+wid*8;
  const bf16*vsrc=Vh+(long)(16*(wid&3)+(lane>>2))*IP+(wid>>2)*32+(lane&3)*8;
  const unsigned kdst=lds0+LDS_K+wid*1024, vdst=lds0+LDS_V+wid*1024;
  #define DMA_K(t,slot) glds16(ksrc+(long)(t)*KVBLK*IP,(unsigned)__builtin_amdgcn_readfirstlane(kdst+(slot)))
  #define DMA_V(t,slot) glds16(vsrc+(long)(t)*KVBLK*IP,(unsigned)__builtin_amdgcn_readfirstlane(vdst+(slot)))
  const int vb0=(int)(lds0+LDS_V)+((lane>>4)&1)*32+(lane&3)*8+(4*hi+((lane&15)>>2))*64;
  const char*Kbase=shm+LDS_K; bf16x8 kf[8];
  const lds_cptr shm3=(lds_cptr)shm; const lds_cptr kp0=shm3+LDS_K+hi*1024+r32*16; const lds_cptr vp0=shm3+LDS_V+((lane>>4)&1)*32+(lane&3)*8+(4*hi+((lane&15)>>2))*64;
  const int NT=(q0+QB)/KVBLK-j0;
  DMA_K(0,0);DMA_V(0,0);DMA_K(1,SLOTB);
  float mhat=0.f,l_reg=0.f,gqm=Gq;f32x16 o[2];o[0]=f32x16{};o[1]=f32x16{};
  #define CINIT(C0,C1,t) do{ const lds_f4p gp_=gl0+16*(t); \
    _Pragma("unroll") for(int a_=0;a_<4;++a_){ const f32x4v g0_=gp_[2*a_],g1_=gp_[8+2*a_]; \
      C0[4*a_]=gqm-g0_.x;C0[4*a_+1]=gqm-g0_.y;C0[4*a_+2]=gqm-g0_.z;C0[4*a_+3]=gqm-g0_.w; \
      C1[4*a_]=gqm-g1_.x;C1[4*a_+1]=gqm-g1_.y;C1[4*a_+2]=gqm-g1_.z;C1[4*a_+3]=gqm-g1_.w; SBAR(); } }while(0)
  const int qrel=wid*QBLK+r32;
  #define CMASK(P0,P1,t) do{int jb_=(t)-(NT-4); if(jb_>=0)cmask(P0,P1,jb_,qrel,hi);}while(0)
  bool resc=false;
  #define START(P0,P1) do{ const float rm=rowmax(P0,P1); resc=false; \
    { const float dl=rm; mhat=fadd_s(mhat,dl); \
      _Pragma("unroll") for(int r=0;r<16;++r){P0[r]=fsub_s(P0[r],dl);P1[r]=fsub_s(P1[r],dl);} \
      gqm=fsub_s(gqm,dl); } \
    _Pragma("unroll") for(int r=0;r<16;++r)P0[r]=__builtin_amdgcn_exp2f(P0[r]); }while(0)
  #define RESC() do{ if(resc){ asm volatile("s_waitcnt lgkmcnt(0)":::"memory"); \
      _Pragma("unroll") for(int d_=0;d_<2;++d_) _Pragma("unroll") for(int r=0;r<16;++r)o[d_][r]*=wsf[crow(r,hi)]; } }while(0)
  f32x16 pA0,pA1,pB0,pB1;
  int sl_prev=0,sl_cur=0,sl_next=SLOTB;
  #define ROT() do{sl_prev=sl_cur;sl_cur=sl_next;sl_next=(sl_next==(NSLOT-1)*SLOTB)?0:sl_next+SLOTB;}while(0)
  DMA_K(2,2*SLOTB);
  WAIT_BAR(3);
  CINIT(pA0,pA1,0); qkt(pA0,pA1,Kbase,qr,r32,hi);asm volatile("s_nop 15\n\ts_nop 7":"+v"(pA0),"+v"(pA1));CMASK(pA0,pA1,0);
  START(pA0,pA1);
  _Pragma("unroll") for(int r=0;r<16;++r)pA1[r]=__builtin_amdgcn_exp2f(pA1[r]);
  WAIT_BAR(0);
  DMA_K(3,0);DMA_V(1,SLOTB);
  ROT();
  kload8(kf,kp0+sl_cur);
  WAIT_BAR(2);
  s16x4 vlo[8],vhi[8]; u32x4 pw0,pw1,pw2,pw3;
  #define PKW(P,B) cvtpk_s(P[B],P[B+1])
  #define PAF(k) __builtin_bit_cast(bf16x8,pw##k)
  #define VFR(i) (bf16x8){vlo[i][0],vlo[i][1],vlo[i][2],vlo[i][3],vhi[i][0],vhi[i][1],vhi[i][2],vhi[i][3]}
  #define PIN(x) asm volatile("":"+v"(x))
  #define MX3(a,b,c) __builtin_fmaxf(__builtin_fmaxf((a),(b)),(c))
  #define GAPA(MF,A0,A1,A2,A3,W0,W1,PW) do{ MF; sacc+=A0; sacc+=A1; sacc+=A2; sacc+=A3; PIN(sacc); W0; W1; PIN(PW); SBAR(); }while(0)
  #define EX(v) __builtin_amdgcn_exp2f(v)
  #define GAPB(MF,X,B,GN,PX,A4,OFF) do{ f32x4v g_; if(GN){g_=gpn_[OFF];} MF; X[B]=EX(X[B]); X[B+1]=EX(X[B+1]); X[B+2]=EX(X[B+2]); X[B+3]=EX(X[B+3]); PIN(X); \
      if(GN){PX[A4]=gqm-g_.x;PX[A4+1]=gqm-g_.y;PX[A4+2]=gqm-g_.z;PX[A4+3]=gqm-g_.w;PIN(PX);} SBAR(); }while(0)
  #define VRD(i) do{ vlo[i]=vtr(vp_+(((i)>>2)*4096+((i)&3)*1024)); vhi[i]=vtr(vp_+(((i)>>2)*4096+((i)&3)*1024+512)); }while(0)
  #define KRD(G,j) do{ if(G){ kload2(kf,kp0+sl_next,j); SBAR(); } }while(0)
  #define STEP(C0,C1,P0,P1,t,GK,GV,GL,GN) do{ SBAR(); const lds_f4p gpn_=gl0+16*((t)+1); \
    const lds_cptr vp_=vp0+sl_prev; \
    VRD(0); SBAR(); float sacc=(P0[0]+P0[1]); \
    GAPA(C0=__builtin_amdgcn_mfma_f32_32x32x16_bf16(kf[0],qr[0],C0,0,0,0), P0[2],P0[3],P0[4],P0[5],     pw0[0]=PKW(P0,0), pw0[1]=PKW(P0,2), pw0); \
    VRD(4); SBAR(); GAPA(C1=__builtin_amdgcn_mfma_f32_32x32x16_bf16(kf[1],qr[0],C1,0,0,0), P0[6],P0[7],P0[8],P0[9],     pw0[2]=PKW(P0,4), pw0[3]=PKW(P0,6), pw0); \
    VRD(1); SBAR(); GAPA(C0=__builtin_amdgcn_mfma_f32_32x32x16_bf16(kf[2],qr[1],C0,0,0,0),   P0[10],P0[11],P0[12],P0[13], pw1[0]=PKW(P0,8), pw1[1]=PKW(P0,10), pw1); \
    VRD(5); SBAR(); GAPA(C1=__builtin_amdgcn_mfma_f32_32x32x16_bf16(kf[3],qr[1],C1,0,0,0),   P0[14],P0[15],P1[0],P1[1],   pw1[2]=PKW(P0,12),pw1[3]=PKW(P0,14), pw1); \
    VRD(2); SBAR(); GAPA(C0=__builtin_amdgcn_mfma_f32_32x32x16_bf16(kf[4],qr[2],C0,0,0,0),   P1[2],P1[3],P1[4],P1[5],     pw2[0]=PKW(P1,0), pw2[1]=PKW(P1,2), pw2); \
    VRD(6); SBAR(); GAPA(C1=__builtin_amdgcn_mfma_f32_32x32x16_bf16(kf[5],qr[2],C1,0,0,0),   P1[6],P1[7],P1[8],P1[9],     pw2[2]=PKW(P1,4), pw2[3]=PKW(P1,6), pw2); \
    VRD(3); SBAR(); GAPA(C0=__builtin_amdgcn_mfma_f32_32x32x16_bf16(kf[6],qr[3],C0,0,0,0),   P1[10],P1[11],P1[12],P1[13], pw3[0]=PKW(P1,8), pw3[1]=PKW(P1,10), pw3); \
    VRD(7); SBAR(); GAPA(C1=__builtin_amdgcn_mfma_f32_32x32x16_bf16(kf[7],qr[3],C1,0,0,0),   P1[14],P1[15],0.f,0.f,       pw3[2]=PKW(P1,12),pw3[3]=PKW(P1,14), pw3); \
    l_reg+=sacc; \
    if(GK){DMA_K((t)+3,sl_cur);} if(GV){DMA_V((t)+1,sl_next);} \
    CMASK(C0,C1,t); \
    { float a=MX3(C0[0],C0[1],C1[0]),b=MX3(C0[2],C0[3],C1[1]); a=MX3(a,C1[2],C1[3]); \
      _Pragma("unroll") for(int r=4;r<16;r+=4){a=MX3(a,C0[r],C0[r+1]);b=MX3(b,C0[r+2],C0[r+3]);a=MX3(a,C1[r],C1[r+1]);b=MX3(b,C1[r+2],C1[r+3]);} \
      float rm=__builtin_fmaxf(a,b); { auto rr=__builtin_amdgcn_permlane32_swap(__float_as_uint(rm),__float_as_uint(rm),false,false); rm=__builtin_fmaxf(__uint_as_float(rr[0]),__uint_as_float(rr[1])); } \
      resc=false; \
      if(__builtin_expect(__any(rm>(float)THRL),0)){ const float dl=__builtin_fmaxf(rm,0.f); mhat+=dl; \
        _Pragma("unroll") for(int r=0;r<16;++r){C0[r]-=dl;C1[r]-=dl;} \
        gqm-=dl; \
        const float f=__builtin_amdgcn_exp2f(-dl); l_reg*=f; if(hi==0)wsf[r32]=f; resc=true; } } \
    SBAR(); \
    GAPB(o[0]=__builtin_amdgcn_mfma_f32_32x32x16_bf16(PAF(0),VFR(0),o[0],0,0,0), C0,0,  GN,P0,0,0); \
    GAPB(o[1]=__builtin_amdgcn_mfma_f32_32x32x16_bf16(PAF(0),VFR(4),o[1],0,0,0), C0,4,  GN,P0,4,2); \
    KRD(GL,0); GAPB(o[0]=__builtin_amdgcn_mfma_f32_32x32x16_bf16(PAF(1),VFR(1),o[0],0,0,0), C0,8,  GN,P0,8,4); \
    KRD(GL,1); GAPB(o[1]=__builtin_amdgcn_mfma_f32_32x32x16_bf16(PAF(1),VFR(5),o[1],0,0,0), C0,12, GN,P0,12,6); \
    KRD(GL,2); GAPB(o[0]=__builtin_amdgcn_mfma_f32_32x32x16_bf16(PAF(2),VFR(2),o[0],0,0,0), C1,0,  GN,P1,0,8); \
    KRD(GL,3); GAPB(o[1]=__builtin_amdgcn_mfma_f32_32x32x16_bf16(PAF(2),VFR(6),o[1],0,0,0), C1,4,  GN,P1,4,10); \
    GAPB(o[0]=__builtin_amdgcn_mfma_f32_32x32x16_bf16(PAF(3),VFR(3),o[0],0,0,0), C1,8,  GN,P1,8,12); \
    GAPB(o[1]=__builtin_amdgcn_mfma_f32_32x32x16_bf16(PAF(3),VFR(7),o[1],0,0,0), C1,12, GN,P1,12,14); \
    }while(0)
  int t=1;
  CINIT(pB0,pB1,1);
  #undef CMASK
  #define CMASK(P0,P1,t) do{}while(0)
  for(;t+5<NT;t+=2){
    STEP(pB0,pB1,pA0,pA1,t,true,true,true,true);     WAIT_BAR(2); RESC(); ROT();
    STEP(pA0,pA1,pB0,pB1,t+1,true,true,true,true);   WAIT_BAR(2); RESC(); ROT();
  }
  #undef CMASK
  #define CMASK(P0,P1,t) do{int jb_=(t)-(NT-4); if(jb_>=0)cmask(P0,P1,jb_,qrel,hi);}while(0)
  #define ENDW(tt) do{ if((tt)+3<NT){WAIT_BAR(2);} else if((tt)+2<NT){WAIT_BAR(1);} else {WAIT_BAR(0);} }while(0)
  for(;t+1<NT;t+=2){
    STEP(pB0,pB1,pA0,pA1,t,(t+3<NT),(t+1<NT),(t+1<NT),true);       ENDW(t);   RESC(); ROT();
    STEP(pA0,pA1,pB0,pB1,t+1,(t+4<NT),(t+2<NT),(t+2<NT),true);     ENDW(t+1); RESC(); ROT();
  }
  STEP(pB0,pB1,pA0,pA1,NT-1,false,false,false,false); RESC();
  { float sacc=pB0[0]+pB0[1]; _Pragma("unroll") for(int r=2;r<16;++r)sacc+=pB0[r]; _Pragma("unroll") for(int r=0;r<16;++r)sacc+=pB1[r]; l_reg+=sacc;
    pw0=(u32x4){PKW(pB0,0),PKW(pB0,2),PKW(pB0,4),PKW(pB0,6)};pw1=(u32x4){PKW(pB0,8),PKW(pB0,10),PKW(pB0,12),PKW(pB0,14)};pw2=(u32x4){PKW(pB1,0),PKW(pB1,2),PKW(pB1,4),PKW(pB1,6)};pw3=(u32x4){PKW(pB1,8),PKW(pB1,10),PKW(pB1,12),PKW(pB1,14)};
    SBAR(); pv(o,vb0+sl_cur,PAF(0),PAF(1),PAF(2),PAF(3)); }
  #undef PKW
  #undef PAF
  #undef VFR
  #undef PIN
  #undef MX3
  #undef GAPA
  #undef GAPB
  #undef EX
  #undef VRD
  #undef KRD
  #undef STEP
  #undef ENDW
  {auto rr=__builtin_amdgcn_permlane32_swap(__float_as_uint(l_reg),__float_as_uint(l_reg),false,false);l_reg=__uint_as_float(rr[0])+__uint_as_float(rr[1]);}
  if(hi==0)wsf[32+r32]=l_reg;asm volatile("s_waitcnt lgkmcnt(0)":::"memory");
  float rli[16];
  #pragma unroll
  for(int r=0;r<16;++r)rli[r]=__builtin_amdgcn_rcpf(wsf[32+crow(r,hi)]);
  bf16*Ow=O+(rowbase+q0+wid*QBLK)*OP+h*D;
  { bf16*stg=(bf16*)(shm+LDS_OST)+wid*2048;
    #pragma unroll
    for(int r=0;r<16;++r){const int orow=crow(r,hi);
      #pragma unroll
      for(int d0=0;d0<2;++d0)stg[orow*64+d0*32+r32]=__float2bfloat16(o[d0][r]*rli[r]);}
    asm volatile("s_waitcnt lgkmcnt(0)":::"memory");
    int le=lane; asm volatile("":"+v"(le));
    #pragma unroll
    for(int i=0;i<4;++i){const int row=i*8+(le>>3),ch=le&7; const u32x4 v=*(const u32x4*)(stg+row*64+ch*8); ATTN_STORE16(Ow+(long)row*OP+ch*8,v);
      float sq=0.f;
      #pragma unroll
      for(int j=0;j<4;++j){const float lo_=__uint_as_float(v[j]<<16),hi_=__uint_as_float(v[j]&0xffff0000u);sq+=lo_*lo_+hi_*hi_;}
      sq+=__uint_as_float((unsigned)__builtin_amdgcn_update_dpp(0,(int)__float_as_uint(sq),0xB1,0xF,0xF,false));
      sq+=__uint_as_float((unsigned)__builtin_amdgcn_update_dpp(0,(int)__float_as_uint(sq),0x4E,0xF,0xF,false));
      sq+=__uint_as_float((unsigned)__builtin_amdgcn_update_dpp(0,(int)__float_as_uint(sq),0x141,0xF,0xF,false));
      if(ch==0)atomicAdd(RSQ+rowbase+q0+wid*QBLK+row,(unsigned long long)(sq*16777216.f));} }
  asm volatile("s_waitcnt lgkmcnt(0)\n\ts_barrier":::"memory");
  #undef DMA_K
  #undef DMA_V
  #undef CMASK
  #undef START
  #undef RESC
  #undef ROT
  #undef CINIT
}
constexpr int ATTN_LDS_BYTES=LDS_BYTES;
struct AttnTensors { const bf16* Q; const bf16* K; const bf16* V; bf16* O; const float* ZFt; const float* bf; unsigned long long* RSQ; const unsigned long long* KN2; };
struct AttnUnit { int bh; int qb; };
struct StaticOrder {
  int vcu;
  __device__ __forceinline__ explicit StaticOrder(int grid,int block):vcu((block%8)*(grid/8)+block/8){}
  __device__ __forceinline__ bool next(int i,AttnUnit&u)const{ if(i>=2)return false; const int s=vcu&15; u.bh=vcu>>4; u.qb=(i==0)?31-s:s; return true; }
  __device__ __forceinline__ void a_ready(const AttnUnit&)const{}
  __device__ __forceinline__ void done(const AttnUnit&)const{}
};
template<int THRL=60> __device__ __forceinline__ void attn_phase_dyn(char*lds,const AttnTensors&T,unsigned*qctr,int block,const ::QuantJob&J,const ::WeightJob&WJ){
  const int nside=::QUANT_UNITS+::weight_units(WJ);
  __attribute__((address_space(3))) int*uw=(__attribute__((address_space(3))) int*)(lds+LDS_WS)+24;
  for(;;){
    const int tn=::tid_now();
    if(tn==0)*uw=(int)atomicAdd(qctr,1u);
    __syncthreads();
    const int ix=__builtin_amdgcn_readfirstlane(*(volatile __attribute__((address_space(3))) int*)uw);
    __syncthreads();
    if(ix>=BATCH*NHEAD*NQB+((nside+1)&~1))break;
    const int jx=ix-256,nsd=(nside+1)&~1,nb3=3*(nsd>>1);
    int u=ix;
    if(jx>=0){
      if(jx<nb3){
        if(jx%3!=2){ const int si=(jx/3)*2+jx%3,wv=__builtin_amdgcn_readfirstlane(tn>>6);
          if(si<nside){ if(si<nside-::QUANT_UNITS) ::weight_unit(WJ,si,(__attribute__((address_space(3))) unsigned char*)lds,wv,tn&63); else ::quant_unit(J,si-(nside-::QUANT_UNITS),wv,tn&63); }
          continue; }
        u=256+jx/3; }
      else u=256+(nsd>>1)+(jx-nb3); }
    const int qb=NQB-1-(u>>4),bh=u&15;
    attn_unit<THRL>(bh>>3,bh&7,qb,T.Q,T.K,T.V,T.O,T.ZFt,T.bf[bh&7],T.RSQ,T.KN2,lds);
  }
}
template<class Sched,int THRL=60> __device__ __forceinline__ void attn_phase(char*lds,const AttnTensors&T,const Sched&S){
  AttnUnit u;
  for(int i=0;S.next(i,u);++i){ S.a_ready(u); attn_unit<THRL>(u.bh/NHEAD,u.bh%NHEAD,u.qb,T.Q,T.K,T.V,T.O,T.ZFt,T.bf[u.bh%NHEAD],T.RSQ,T.KN2,lds); S.done(u); }
}
#undef SBAR
#undef WAIT_BAR
}

__device__ __forceinline__ float wave_sum(float v) {
    v += __uint_as_float((unsigned)__builtin_amdgcn_update_dpp(0, (int)__float_as_uint(v), 0xB1, 0xF, 0xF, false));
    v += __uint_as_float((unsigned)__builtin_amdgcn_update_dpp(0, (int)__float_as_uint(v), 0x4E, 0xF, 0xF, false));
    v += __uint_as_float((unsigned)__builtin_amdgcn_update_dpp(0, (int)__float_as_uint(v), 0x141, 0xF, 0xF, false));
    v += __uint_as_float((unsigned)__builtin_amdgcn_update_dpp(0, (int)__float_as_uint(v), 0x140, 0xF, 0xF, false));
    v += __uint_as_float((unsigned)__builtin_amdgcn_update_dpp(0, (int)__float_as_uint(v), 0x142, 0xA, 0xF, false));
    v += __uint_as_float((unsigned)__builtin_amdgcn_update_dpp(0, (int)__float_as_uint(v), 0x143, 0xC, 0xF, false));
    return __uint_as_float((unsigned)__builtin_amdgcn_readlane((int)__float_as_uint(v), 63));
}

struct Ctx { int tid, lane, wave, bid, nblk; float* lds; };

template <bool Q8, bool XBF> __device__ __forceinline__ void ph_rmsnorm_bf16(const Ctx& c, const void* X, const float* g, bf16* Y, unsigned char* Y8 = nullptr, float* SH = nullptr, unsigned long long* ZERO = nullptr, unsigned long long* ZKN = nullptr) {
    const int gw = c.bid * NWAVES + c.wave, NGW = c.nblk * NWAVES;
    for (int m0 = gw; m0 < T; m0 += 2 * NGW) {
        float4 v[2][4];
#pragma unroll
        for (int u = 0; u < 2; ++u) { const int m = (m0 + u * NGW < T) ? m0 + u * NGW : m0;
#pragma unroll
            for (int j = 0; j < 4; ++j) {
                if (XBF) { const uint2 rb = ((const uint2*)((const bf16*)X + (size_t)m * D) + c.lane)[64 * j]; v[u][j] = make_float4(bf_lo(rb.x), bf_hi(rb.x), bf_lo(rb.y), bf_hi(rb.y)); }
                else v[u][j] = ((const float4*)((const float*)X + (size_t)m * D) + c.lane)[64 * j]; } }
#pragma unroll
        for (int u = 0; u < 2; ++u) { const int m = m0 + u * NGW; if (m >= T) break;
            float s = 0.f;
#pragma unroll
            for (int j = 0; j < 4; ++j) s += v[u][j].x * v[u][j].x + v[u][j].y * v[u][j].y + v[u][j].z * v[u][j].z + v[u][j].w * v[u][j].w;
            const float r = rsqrtf(wave_sum(s) * (1.f / D) + EPS);
            if (ZERO && c.lane == 0) ZERO[m] = 0ull;
            if (ZKN && c.lane < NH) ZKN[(size_t)((m >> 13) * NH + c.lane) * S + (m & (S - 1))] = 0ull;
            uint2* yr = (uint2*)(Y + (size_t)m * D) + c.lane;
#pragma unroll
            for (int j = 0; j < 4; ++j) { const float4 gg = ((const float4*)g)[c.lane + 64 * j];
                v[u][j] = make_float4(v[u][j].x * r * gg.x, v[u][j].y * r * gg.y, v[u][j].z * r * gg.z, v[u][j].w * r * gg.w);
                yr[64 * j] = make_uint2(pk2(v[u][j].x, v[u][j].y), pk2(v[u][j].z, v[u][j].w)); }
            if (Q8) {
                float am = 0.f;
#pragma unroll
                for (int j = 0; j < 4; ++j) am = fmaxf(am, fmaxf(fmaxf(fabsf(v[u][j].x), fabsf(v[u][j].y)), fmaxf(fabsf(v[u][j].z), fabsf(v[u][j].w))));
                am = wave_max63(am);
                const float inv = am > 0.f ? 127.f / am : 0.f;
                unsigned pk[4];
#pragma unroll
                for (int j = 0; j < 4; ++j) pk[j] = pack4_i8(v[u][j].x, v[u][j].y, v[u][j].z, v[u][j].w, inv);
#pragma unroll
                for (int j = 0; j < 4; ++j) *(unsigned*)(Y8 + (size_t)m * D + 4 * c.lane + 256 * j) = pk[j];
                if (c.lane == 0) SH[m] = am * (1.f / 127.f);
            }
        }
    }
}
__device__ __forceinline__ void ph_rmsnorm(const Ctx& c, const bf16* X, const float* g, float* Y) {
    const int gw = c.bid * NWAVES + c.wave, NGW = c.nblk * NWAVES;
    for (int m = gw; m < T; m += NGW) {
        const uint2* xr = (const uint2*)(X + (size_t)m * D) + c.lane;
        float4 v[4]; float s = 0.f;
#pragma unroll
        for (int j = 0; j < 4; ++j) { const uint2 rb = xr[64 * j]; v[j] = make_float4(bf_lo(rb.x), bf_hi(rb.x), bf_lo(rb.y), bf_hi(rb.y)); s += v[j].x * v[j].x + v[j].y * v[j].y + v[j].z * v[j].z + v[j].w * v[j].w; }
        const float r = rsqrtf(wave_sum(s) * (1.f / D) + EPS);
        float4* yr = (float4*)(Y + (size_t)m * D) + c.lane;
#pragma unroll
        for (int j = 0; j < 4; ++j) { const float4 gg = ((const float4*)g)[c.lane + 64 * j];
            yr[64 * j] = make_float4(v[j].x * r * gg.x, v[j].y * r * gg.y, v[j].z * r * gg.z, v[j].w * r * gg.w); }
    }
}
__device__ __forceinline__ void ph_prologue(const Ctx& c, const WeightJob& W) {
    LAS float* scr = weight_scr((LAS unsigned char*)c.lds, c.wave);
    const int gw = c.bid * NWAVES + c.wave, NGW = c.nblk * NWAVES;
    for (int it = W.it0 + gw; it < W.it1; it += NGW) weight_item(W, it, scr, c.lane);
}

__device__ __forceinline__ float bfv(const bf16* p) { return __builtin_bit_cast(float, (unsigned)(*p) << 16); }
__device__ __forceinline__ float gelu_fast(float x) {
    const float u = 0.7978845608028654f * (x + 0.044715f * x * x * x);
    const float e = __expf(2.f * u);
    return 0.5f * x * (2.f - 2.f * __builtin_amdgcn_rcpf(e + 1.f));
}
__device__ __forceinline__ float dpp_row_sum16(float v) {
    v += __builtin_bit_cast(float, __builtin_amdgcn_update_dpp(0, __builtin_bit_cast(int, v), 0xB1, 0xF, 0xF, false));
    v += __builtin_bit_cast(float, __builtin_amdgcn_update_dpp(0, __builtin_bit_cast(int, v), 0x4E, 0xF, 0xF, false));
    v += __builtin_bit_cast(float, __builtin_amdgcn_update_dpp(0, __builtin_bit_cast(int, v), 0x141, 0xF, 0xF, false));
    v += __builtin_bit_cast(float, __builtin_amdgcn_update_dpp(0, __builtin_bit_cast(int, v), 0x140, 0xF, 0xF, false));
    return v;
}
constexpr int VNT_PITCH = 136;
__device__ __forceinline__ void mixlocal_unit(const Ctx& c, int u, const bf16* ZB, const float* wsp, const float* bsp, const float* sgu, const float* convw, const float* gmix, bf16* MIXN) {
    const int chk = u >> 1, hf = u & 1, trow0 = chk * CHUNK, ns = 64 * (hf + 1);
    LAS unsigned short* VNt = (LAS unsigned short*)c.lds;
    LAS float* RS = (LAS float*)((LAS unsigned char*)c.lds + 4 * 64 * VNT_PITCH * 2);
    uint4 raw8[8];
#pragma unroll
    for (int k = 0; k < 8; ++k) { const int it = c.tid + k * NTHR; if (it < ns * 32) { const int sI = ((it >> 8) << 3) + ((it >> 3) & 7), g = (it >> 6) & 3, oct = it & 7;
        raw8[k] = *(const uint4*)(ZB + (size_t)(trow0 + sI) * ZC + NGV + g * 64 + oct * 8); } }
    float4 wA[4][2][2]; unsigned short guv[2][4][4];
    { const int g = c.wave >> 1, rs = c.wave & 1, m = c.lane & 15, kq = c.lane >> 4; const int tl0 = 64 * hf + 32 * rs, nks = (tl0 + 32) / 32;
#pragma unroll
      for (int mt = 0; mt < 2; ++mt)
#pragma unroll
        for (int r = 0; r < 4; ++r) { const bf16* gur = ZB + (size_t)(trow0 + tl0 + 16 * mt + 4 * kq + r) * ZC + NGU + g * 64 + m;
#pragma unroll
            for (int nt = 0; nt < 4; ++nt) guv[mt][r][nt] = *(const unsigned short*)(gur + 16 * nt); }
#pragma unroll
      for (int ks = 0; ks < 4; ++ks) if (ks < nks) {
#pragma unroll
        for (int mt = 0; mt < 2; ++mt) { const float* wr = wsp + ((size_t)g * CHUNK + tl0 + 16 * mt + m) * CHUNK + 32 * ks + 8 * kq;
            wA[ks][mt][0] = *(const float4*)wr; wA[ks][mt][1] = *(const float4*)(wr + 4); } } }
#pragma unroll
    for (int k = 0; k < 8; ++k) { const int it = c.tid + k * NTHR; if (it < ns * 32) {
        const int sI = ((it >> 8) << 3) + ((it >> 3) & 7), g = (it >> 6) & 3, oct = it & 7;
        const uint4 raw = raw8[k];
        float v[8] = {bf_lo(raw.x), bf_hi(raw.x), bf_lo(raw.y), bf_hi(raw.y), bf_lo(raw.z), bf_hi(raw.z), bf_lo(raw.w), bf_hi(raw.w)};
        float ss = 0.f;
#pragma unroll
        for (int j = 0; j < 8; ++j) { v[j] = gelu_fast(v[j]); ss += v[j] * v[j]; }
        ss += __uint_as_float((unsigned)__builtin_amdgcn_update_dpp(0, (int)__float_as_uint(ss), 0xB1, 0xF, 0xF, false));
        ss += __uint_as_float((unsigned)__builtin_amdgcn_update_dpp(0, (int)__float_as_uint(ss), 0x4E, 0xF, 0xF, false));
        ss += __uint_as_float((unsigned)__builtin_amdgcn_update_dpp(0, (int)__float_as_uint(ss), 0x141, 0xF, 0xF, false));
        const float r = rsqrtf(ss * (1.f / 64.f) + EPS);
#pragma unroll
        for (int j = 0; j < 8; ++j) VNt[(g * 64 + oct * 8 + j) * VNT_PITCH + ((((sI >> 3) ^ oct) << 3) | (sI & 7))] = (unsigned short)f2bf(v[j] * r * sgu[g * 64 + oct * 8 + j]);
    } }
    __syncthreads();
    uint2 cvc[10], cvi[10], cvb[8]; const int cv_tg = trow0 + 64 * hf + 8 * c.wave, cv_ch = 4 * c.lane, cv_pos0 = cv_tg & (S - 1);
    {
        const int g = c.wave >> 1, rs = c.wave & 1, m = c.lane & 15, kq = c.lane >> 4;
        const int tl0 = 64 * hf + 32 * rs, nks = (tl0 + 32) / 32;
        pg8::f32x4 acc[2][4];
#pragma unroll
        for (int mt = 0; mt < 2; ++mt)
#pragma unroll
            for (int nt = 0; nt < 4; ++nt) acc[mt][nt] = (pg8::f32x4){0.f, 0.f, 0.f, 0.f};
#pragma unroll
        for (int ks = 0; ks < 4; ++ks) if (ks < nks) {
            pg8::bf16x8 af[2], bfr[4];
            const int s0 = 32 * ks + 8 * kq;
#pragma unroll
            for (int mt = 0; mt < 2; ++mt) { const int tau = tl0 + 16 * mt + m;
                const float4 w0 = wA[ks][mt][0], w1 = wA[ks][mt][1];
                const float wv[8] = {w0.x, w0.y, w0.z, w0.w, w1.x, w1.y, w1.z, w1.w};
                unsigned pk[4];
#pragma unroll
                for (int j = 0; j < 4; ++j) pk[j] = pk2((s0 + 2 * j <= tau) ? wv[2 * j] : 0.f, (s0 + 2 * j + 1 <= tau) ? wv[2 * j + 1] : 0.f);
                af[mt] = __builtin_bit_cast(pg8::bf16x8, (pg8::u32x4){pk[0], pk[1], pk[2], pk[3]}); }
#pragma unroll
            for (int nt = 0; nt < 4; ++nt) bfr[nt] = *(const LAS pg8::bf16x8*)(VNt + (g * 64 + 16 * nt + m) * VNT_PITCH + ((((s0 >> 3) ^ (((16 * nt + m) >> 3) & 7))) << 3));
#pragma unroll
            for (int mt = 0; mt < 2; ++mt)
#pragma unroll
                for (int nt = 0; nt < 4; ++nt) acc[mt][nt] = __builtin_amdgcn_mfma_f32_16x16x32_bf16(af[mt], bfr[nt], acc[mt][nt], 0, 0, 0);
        }
#pragma unroll
        for (int i = 0; i < 10; ++i) { const int row = cv_tg - 2 + i; const bool ok = (i >= 2) || (cv_pos0 >= 2 - i);
            cvc[i] = ok ? *(const uint2*)(ZB + (size_t)row * ZC + NCC + cv_ch) : make_uint2(0u, 0u); cvi[i] = ok ? *(const uint2*)(ZB + (size_t)row * ZC + NCI + cv_ch) : make_uint2(0u, 0u); }
#pragma unroll
        for (int i = 0; i < 8; ++i) cvb[i] = *(const uint2*)(ZB + (size_t)(cv_tg + i) * ZC + NCB + cv_ch);
        float sq[2][4];
#pragma unroll
        for (int mt = 0; mt < 2; ++mt)
#pragma unroll
            for (int r = 0; r < 4; ++r) { const int tau = tl0 + 16 * mt + 4 * kq + r; const float bias = bsp[g * CHUNK + tau];
                float q = 0.f;
#pragma unroll
                for (int nt = 0; nt < 4; ++nt) { const float val = gelu_fast(__uint_as_float((unsigned)guv[mt][r][nt] << 16)) * (acc[mt][nt][r] + bias); acc[mt][nt][r] = val; q += val * val; }
                sq[mt][r] = dpp_row_sum16(q); }
        if (m == 0) {
#pragma unroll
            for (int mt = 0; mt < 2; ++mt)
#pragma unroll
                for (int r = 0; r < 4; ++r) RS[g * 64 + 32 * rs + 16 * mt + 4 * kq + r] = sq[mt][r];
        }
        __syncthreads();
#pragma unroll
        for (int mt = 0; mt < 2; ++mt)
#pragma unroll
            for (int r = 0; r < 4; ++r) { const int lr = 32 * rs + 16 * mt + 4 * kq + r, tau = 64 * hf + lr;
                const float rstd = rsqrtf((RS[lr] + RS[64 + lr] + RS[128 + lr] + RS[192 + lr]) * (1.f / 256.f) + EPS);
                bf16* orow = MIXN + (size_t)(trow0 + tau) * D + 512 + g * 64 + m;
#pragma unroll
                for (int nt = 0; nt < 4; ++nt) orow[16 * nt] = (bf16)f2bf(acc[mt][nt][r] * rstd * gmix[512 + g * 64 + 16 * nt + m]); }
    }
    {
        const int tl = 64 * hf + 8 * c.wave, tg = trow0 + tl, ch = 4 * c.lane;
        const float4 w0 = *(const float4*)(convw + ch), w1 = *(const float4*)(convw + 256 + ch), w2 = *(const float4*)(convw + 512 + ch);
        const float4 gm = *(const float4*)(gmix + 768 + ch);
        auto zrow = [&](int i) { const uint2 cc = cvc[i], ci = cvi[i];
            return make_float4(bf_lo(cc.x) * bf_lo(ci.x), bf_hi(cc.x) * bf_hi(ci.x), bf_lo(cc.y) * bf_lo(ci.y), bf_hi(cc.y) * bf_hi(ci.y)); };
        float4 zm2 = zrow(0), zm1 = zrow(1);
#pragma unroll
        for (int i = 0; i < 8; ++i) {
            const float4 z0 = zrow(i + 2);
            const uint2 cb = cvb[i];
            float4 o;
            o.x = bf_lo(cb.x) * (w0.x * zm2.x + w1.x * zm1.x + w2.x * z0.x); o.y = bf_hi(cb.x) * (w0.y * zm2.y + w1.y * zm1.y + w2.y * z0.y);
            o.z = bf_lo(cb.y) * (w0.z * zm2.z + w1.z * zm1.z + w2.z * z0.z); o.w = bf_hi(cb.y) * (w0.w * zm2.w + w1.w * zm1.w + w2.w * z0.w);
            const float r = rsqrtf(wave_sum(o.x * o.x + o.y * o.y + o.z * o.z + o.w * o.w) * (1.f / 256.f) + EPS);
            *(uint2*)(MIXN + (size_t)(tg + i) * D + 768 + ch) = make_uint2(pk2(o.x * r * gm.x, o.y * r * gm.y), pk2(o.z * r * gm.z, o.w * r * gm.w));
            zm2 = zm1; zm1 = z0;
        }
    }
    __syncthreads();
}
__device__ __forceinline__ void tk_insert(float (&v)[16], int (&ix)[16], float s, int k) {
    if (s > v[15]) {
        v[15] = s; ix[15] = k;
#pragma unroll
        for (int j = 15; j > 0; --j) {
            const bool sw = v[j] > v[j - 1];
            const float a = v[j], bq = v[j - 1]; const int ia = ix[j], ib = ix[j - 1];
            v[j - 1] = sw ? a : bq; v[j] = sw ? bq : a; ix[j - 1] = sw ? ia : ib; ix[j] = sw ? ib : ia;
        }
    }
}
__device__ __forceinline__ float vmaxf(float a, float b) { float r; asm("v_max_f32_e32 %0, %1, %2" : "=v"(r) : "v"(a), "v"(b)); return r; }
__device__ __forceinline__ float vminf(float a, float b) { float r; asm("v_min_f32_e32 %0, %1, %2" : "=v"(r) : "v"(a), "v"(b)); return r; }
__device__ __forceinline__ void bitonic_sort16_desc(float (&v)[16]) {
#pragma unroll
    for (int k = 2; k <= 16; k <<= 1)
#pragma unroll
        for (int j = k >> 1; j > 0; j >>= 1)
#pragma unroll
            for (int i = 0; i < 16; ++i) { const int l = i ^ j;
                if (l > i) { const float hi = vmaxf(v[i], v[l]), lo = vminf(v[i], v[l]); const bool desc = ((i & k) == 0) || (k == 16);
                    v[i] = desc ? hi : lo; v[l] = desc ? lo : hi; } }
}
__device__ __forceinline__ void merge_top16_desc(float (&a)[16], const float (&b)[16]) {
#pragma unroll
    for (int i = 0; i < 16; ++i) a[i] = vmaxf(a[i], b[15 - i]);
#pragma unroll
    for (int j = 8; j > 0; j >>= 1)
#pragma unroll
        for (int i = 0; i < 16; ++i) { const int l = i ^ j; if (l > i) { const float hi = vmaxf(a[i], a[l]), lo = vminf(a[i], a[l]); a[i] = hi; a[l] = lo; } }
}
constexpr int SKL_PITCH = 136;
template <bool LOCAL> __device__ __forceinline__ void ph_topk1_mfma(const Ctx& c, const bf16* Q, const float* sk, float* TV, int* TI, int lt0 = 0, int lt1 = 0) {
    typedef float f32x16 __attribute__((ext_vector_type(16)));
    LAS unsigned short* SKl = (LAS unsigned short*)c.lds;
    for (int i = c.tid; i < 2 * NKEYS * DHALF / 4; i += NTHR) { const float4 x = ((const float4*)sk)[i]; const int row = i >> 5, c4 = i & 31;
        typedef unsigned u32x2v __attribute__((ext_vector_type(2))); *(LAS u32x2v*)(SKl + row * SKL_PITCH + c4 * 4) = (u32x2v){pk2(x.x, x.y), pk2(x.z, x.w)}; }
    __syncthreads();
    const int r32 = c.lane & 31, hi = c.lane >> 5;
    const int gw = c.bid * NWAVES + c.wave, NGW = c.nblk * NWAVES;
    for (int b = LOCAL ? c.wave : gw; b < (LOCAL ? 32 : T * PH * 2 / 32); b += (LOCAL ? NWAVES : NGW)) {
        const int half = b & 1; int L = (b >> 1) * 32 + r32;
        if (LOCAL) { const int lt = (b >> 4) ? lt1 : lt0; L = ((lt >> 3) * 256 + ((b >> 1) & 7) * 32 + r32) * 8 + (lt & 7); }
        const bf16* qp = Q + (size_t)L * DKEY + half * DHALF + 8 * hi;
        pg8::bf16x8 qf[8];
#pragma unroll
        for (int ks = 0; ks < 8; ++ks) qf[ks] = *(const pg8::bf16x8*)(qp + 16 * ks);
        f32x16 acc[4];
#pragma unroll
        for (int kb = 0; kb < 4; ++kb) acc[kb] = f32x16{};
        int aoff = (half * NKEYS + r32) * SKL_PITCH + 8 * hi; asm volatile("" : "+v"(aoff));
        const LAS unsigned short* ap = SKl + aoff;
#pragma unroll
        for (int ks = 0; ks < 8; ++ks) {
#pragma unroll
            for (int kb = 0; kb < 4; ++kb) { const pg8::bf16x8 af = *(const LAS pg8::bf16x8*)(ap + kb * 32 * SKL_PITCH + 16 * ks);
                acc[kb] = __builtin_amdgcn_mfma_f32_32x32x16_bf16(af, qf[ks], acc[kb], 0, 0, 0); }
        }
        float v0[16], v1[16], v2[16], v3[16];
#pragma unroll
        for (int r = 0; r < 16; ++r) { const unsigned key = (unsigned)((r & 3) + 8 * (r >> 2) + 4 * hi);
            const float a0 = acc[0][r], a1 = acc[1][r], a2 = acc[2][r], a3 = acc[3][r];
            v0[r] = __uint_as_float((__float_as_uint(a0) & ~127u) | key);
            v1[r] = __uint_as_float((__float_as_uint(a1) & ~127u) | (key + 32u));
            v2[r] = __uint_as_float((__float_as_uint(a2) & ~127u) | (key + 64u));
            v3[r] = __uint_as_float((__float_as_uint(a3) & ~127u) | (key + 96u)); }
        bitonic_sort16_desc(v0); bitonic_sort16_desc(v1); bitonic_sort16_desc(v2); bitonic_sort16_desc(v3);
        merge_top16_desc(v0, v1); merge_top16_desc(v2, v3); merge_top16_desc(v0, v2);
#pragma unroll
        for (int r = 0; r < 16; ++r) { const unsigned x = __builtin_bit_cast(unsigned, v0[r]); auto rr = __builtin_amdgcn_permlane32_swap(x, x, false, false);
            v1[r] = __builtin_bit_cast(float, hi ? rr[0] : rr[1]); }
        merge_top16_desc(v0, v1);
        if (hi == 0) { const size_t o = ((size_t)L * 2 + half) * 16;
#pragma unroll
            for (int j4 = 0; j4 < 4; ++j4) ((float4*)(TV + o))[j4] = make_float4(v0[4 * j4], v0[4 * j4 + 1], v0[4 * j4 + 2], v0[4 * j4 + 3]); }
    }
    __syncthreads();
}
template <bool FUSED, bool LOCAL = false> __device__ __forceinline__ void ph_topk2(const Ctx& c, const float* TV, const int* TI, int* EIDX, float* GATE, int* AI, float* SUK, const float* SU, const float* SV, int lt0 = 0, int lt1 = 0) {
    int it0 = FUSED ? 32 * (c.bid * 4 + ((c.tid >> 5) & 3) + (c.nblk * 4) * (c.tid >> 7)) + (c.tid & 31) : c.bid * NTHR + c.tid;
    if (LOCAL) { const int lt = (c.tid >> 8) ? lt1 : lt0; it0 = ((lt >> 3) * 256 + (c.tid & 255)) * 8 + (lt & 7); }
    for (int it = it0; it < T * PH; it += (FUSED ? T * PH : c.nblk * NTHR)) {
        float v1[16], v2[16]; int i1[16], i2[16];
#pragma unroll
        for (int j4 = 0; j4 < 4; ++j4) {
            const uint4 a = ((const uint4*)(TV + (size_t)it * 32))[j4], b = ((const uint4*)(TV + (size_t)it * 32 + 16))[j4];
            const unsigned aw[4] = {a.x, a.y, a.z, a.w}, bw[4] = {b.x, b.y, b.z, b.w};
#pragma unroll
            for (int k = 0; k < 4; ++k) { v1[4 * j4 + k] = __uint_as_float(aw[k] & ~127u); i1[4 * j4 + k] = (int)(aw[k] & 127u); v2[4 * j4 + k] = __uint_as_float(bw[k] & ~127u); i2[4 * j4 + k] = (int)(bw[k] & 127u); } }
        float cv[16]; int ci[16];
#pragma unroll
        for (int j = 0; j < 16; ++j) { cv[j] = -INFINITY; ci[j] = 0; }
#pragma unroll
        for (int a = 0; a < 16; ++a)
#pragma unroll
            for (int b = 0; b < 16; ++b)
                if ((a + 1) * (b + 1) <= 16) tk_insert(cv, ci, v1[a] + v2[b], i1[a] * NKEYS + i2[b]);
        float sum = 0.f, e[16];
#pragma unroll
        for (int j = 0; j < 16; ++j) { e[j] = __expf(cv[j] - cv[0]); sum += e[j]; }
        const float rs = 1.f / sum;
#pragma unroll
        for (int j = 0; j < 16; ++j) { e[j] = e[j] * rs * SV[ci[j]]; cv[j] = SU[ci[j]]; }
#pragma unroll
        for (int j4 = 0; j4 < 4; ++j4) { ((int4*)(EIDX + (size_t)it * 16))[j4] = make_int4(ci[4 * j4], ci[4 * j4 + 1], ci[4 * j4 + 2], ci[4 * j4 + 3]);
            ((uint4*)(GATE + (size_t)it * 16))[j4] = make_uint4(pk2(e[4 * j4], cv[4 * j4]), pk2(e[4 * j4 + 1], cv[4 * j4 + 1]), pk2(e[4 * j4 + 2], cv[4 * j4 + 2]), pk2(e[4 * j4 + 3], cv[4 * j4 + 3])); }
#pragma unroll
        for (int j4 = 0; j4 < 4; ++j4) ((int4*)(AI + (size_t)it * 16))[j4] = make_int4(0, 0, 0, 0);
    }
}

__device__ __forceinline__ float wave_sum_dpp63(float v) {
    v += __builtin_bit_cast(float, __builtin_amdgcn_update_dpp(0, __builtin_bit_cast(int, v), 0xB1, 0xF, 0xF, false));
    v += __builtin_bit_cast(float, __builtin_amdgcn_update_dpp(0, __builtin_bit_cast(int, v), 0x4E, 0xF, 0xF, false));
    v += __builtin_bit_cast(float, __builtin_amdgcn_update_dpp(0, __builtin_bit_cast(int, v), 0x141, 0xF, 0xF, false));
    v += __builtin_bit_cast(float, __builtin_amdgcn_update_dpp(0, __builtin_bit_cast(int, v), 0x140, 0xF, 0xF, false));
    v += __builtin_bit_cast(float, __builtin_amdgcn_update_dpp(0, __builtin_bit_cast(int, v), 0x142, 0xA, 0xF, false));
    v += __builtin_bit_cast(float, __builtin_amdgcn_update_dpp(0, __builtin_bit_cast(int, v), 0x143, 0xC, 0xF, false));
    return v;
}
__device__ __forceinline__ int wave_sum_dpp63_i(int v) {
    v += __builtin_amdgcn_update_dpp(0, v, 0xB1, 0xF, 0xF, false);
    v += __builtin_amdgcn_update_dpp(0, v, 0x4E, 0xF, 0xF, false);
    v += __builtin_amdgcn_update_dpp(0, v, 0x141, 0xF, 0xF, false);
    v += __builtin_amdgcn_update_dpp(0, v, 0x140, 0xF, 0xF, false);
    v += __builtin_amdgcn_update_dpp(0, v, 0x142, 0xA, 0xF, false);
    v += __builtin_amdgcn_update_dpp(0, v, 0x143, 0xC, 0xF, false);
    return v;
}
template <bool DRY> __device__ __forceinline__ void ph_peer_u(const Ctx& c, const unsigned char* XN8, const int* EIDX, int* AI, const unsigned char* EU) {
    const int j = c.bid & 7, wp = (c.bid >> 3) * NWAVES + c.wave, NWP = (c.nblk >> 3) * NWAVES, NT = T / NWP;
    const int rr = c.lane >> 3, cc = c.lane & 7;
    LAS int* el = (LAS int*)((LAS unsigned char*)c.lds + c.wave * 5120);
    const unsigned char* Up = EU + (size_t)j * NEXP * 128;
    const unsigned cofs = 16u * (unsigned)cc;
#define PU_TOK(n) (wp + ((n) < NT ? (n) : NT - 1) * NWP)
#define PU_META(E0, E1, H, n) do { const unsigned t_ = (unsigned)PU_TOK(n); E0 = EIDX[t_ * 128u + (unsigned)c.lane]; E1 = EIDX[t_ * 128u + 64u + (unsigned)c.lane]; H = *(const uint4*)(XN8 + (t_ * (unsigned)D + 128u * (unsigned)j + cofs)); } while (0)
#define PU_STAGE(R, HS, E0, E1, H) do { el[c.lane] = E0; el[64 + c.lane] = E1; HS = H; \
        _Pragma("unroll") for (int i = 0; i < 16; ++i) { const unsigned e = (unsigned)el[i * 8 + rr]; R[i] = *(const uint4*)(Up + (e * 128u + cofs)); } } while (0)
#define PU_COMPUTE(R, HS, n) do { int resA = 0, resB = 0; \
        _Pragma("unroll") for (int i = 0; i < 16; ++i) { \
            int d = __builtin_amdgcn_sdot4((int)R[i].x, (int)HS.x, 0, false); d = __builtin_amdgcn_sdot4((int)R[i].y, (int)HS.y, d, false); \
            d = __builtin_amdgcn_sdot4((int)R[i].z, (int)HS.z, d, false); d = __builtin_amdgcn_sdot4((int)R[i].w, (int)HS.w, d, false); \
            d += __builtin_amdgcn_update_dpp(0, d, 0xB1, 0xF, 0xF, false); d += __builtin_amdgcn_update_dpp(0, d, 0x4E, 0xF, 0xF, false); d += __builtin_amdgcn_update_dpp(0, d, 0x141, 0xF, 0xF, false); \
            if (i < 8) resA = (cc == i) ? d : resA; else resB = (cc == i - 8) ? d : resB; } \
        if (DRY) { asm volatile("" :: "v"(resA), "v"(resB)); } \
        else { int* ap = AI + ((unsigned)PU_TOK(n) * 128u + (unsigned)(8 * cc + rr)); \
            __hip_atomic_fetch_add(ap, resA, __ATOMIC_RELAXED, __HIP_MEMORY_SCOPE_AGENT); __hip_atomic_fetch_add(ap + 64, resB, __ATOMIC_RELAXED, __HIP_MEMORY_SCOPE_AGENT); } } while (0)
    int mE0, mE1; uint4 mH, hA, hB; uint4 rA[16], rB[16];
    PU_META(mE0, mE1, mH, 0);
    PU_STAGE(rA, hA, mE0, mE1, mH); PU_META(mE0, mE1, mH, 1);
    for (int n = 0; n < NT; n += 2) {
        PU_STAGE(rB, hB, mE0, mE1, mH); PU_META(mE0, mE1, mH, n + 2);
        PU_COMPUTE(rA, hA, n);
        PU_STAGE(rA, hA, mE0, mE1, mH); PU_META(mE0, mE1, mH, n + 3);
        PU_COMPUTE(rB, hB, n + 1);
    }
#undef PU_TOK
#undef PU_META
#undef PU_STAGE
#undef PU_COMPUTE
}
template <bool DRY> __device__ __forceinline__ void ph_peer_v(const Ctx& c, const int* EIDX, const float* GATE, const int* AI, const float* SH, const float* SUK, const unsigned char* EV, bf16* XB) {
    const int j = c.bid & 7, wp = (c.bid >> 3) * NWAVES + c.wave, NWP = (c.nblk >> 3) * NWAVES;
    const int rr = c.lane >> 3, cc = c.lane & 7;
    typedef unsigned u32x2v __attribute__((ext_vector_type(2)));
    typedef float f32x2v __attribute__((ext_vector_type(2)));
    LAS u32x2v* ew = (LAS u32x2v*)((LAS unsigned char*)c.lds + c.wave * 5120);
    LAS float* red = (LAS float*)((LAS unsigned char*)c.lds + c.wave * 5120 + 1024);
    const unsigned char* Vp = EV + (size_t)j * NEXP * 128 + 16 * cc;
    int eB0 = EIDX[(size_t)wp * 128 + c.lane], eB1 = EIDX[(size_t)wp * 128 + 64 + c.lane];
    const unsigned* GS = (const unsigned*)GATE;
    unsigned gB0 = GS[(size_t)wp * 128 + c.lane], gB1 = GS[(size_t)wp * 128 + 64 + c.lane];
    int aB0 = AI[(size_t)wp * 128 + c.lane], aB1 = AI[(size_t)wp * 128 + 64 + c.lane];
    float shB = SH[wp];
    for (int t = wp; t < T; t += NWP) {
        const int e0 = eB0, e1 = eB1;
        const float w0 = gelu_fast((float)aB0 * bf_hi(gB0) * shB) * bf_lo(gB0), w1 = gelu_fast((float)aB1 * bf_hi(gB1) * shB) * bf_lo(gB1);
        { const size_t o1 = (size_t)((t + NWP < T) ? t + NWP : t) * 128 + c.lane;
          eB0 = EIDX[o1]; eB1 = EIDX[o1 + 64]; gB0 = GS[o1]; gB1 = GS[o1 + 64]; aB0 = AI[o1]; aB1 = AI[o1 + 64]; shB = SH[o1 >> 7]; }
        unsigned* xp = (unsigned*)(XB + (size_t)t * D + 128 * j) + c.lane;
        const unsigned xw = *xp; float2 x = make_float2(bf_lo(xw), bf_hi(xw));
        ew[c.lane] = (u32x2v){(unsigned)e0, __float_as_uint(w0)}; ew[64 + c.lane] = (u32x2v){(unsigned)e1, __float_as_uint(w1)};
        f32x2v acc[8];
#pragma unroll
        for (int m = 0; m < 8; ++m) acc[m] = (f32x2v){0.f, 0.f};
        uint4 r[16]; float wv[16];
#pragma unroll
        for (int i = 0; i < 16; ++i) { const u32x2v p = ew[i * 8 + rr]; wv[i] = __uint_as_float(p.y); r[i] = *(const uint4*)(Vp + (size_t)p.x * 128); }
#pragma unroll
        for (int i = 0; i < 16; ++i) { const int dw[4] = {(int)r[i].x, (int)r[i].y, (int)r[i].z, (int)r[i].w}; const f32x2v ww = (f32x2v){wv[i], wv[i]};
#pragma unroll
            for (int q = 0; q < 4; ++q) {
                acc[2 * q] = __builtin_elementwise_fma(ww, __builtin_amdgcn_cvt_pk_f32_fp8(dw[q], false), acc[2 * q]);
                acc[2 * q + 1] = __builtin_elementwise_fma(ww, __builtin_amdgcn_cvt_pk_f32_fp8(dw[q], true), acc[2 * q + 1]); } }
#pragma unroll
        for (int q = 0; q < 4; ++q) *(LAS pg8::f32x4*)(red + rr * 128 + 16 * cc + 4 * q) = (pg8::f32x4){acc[2 * q].x, acc[2 * q].y, acc[2 * q + 1].x, acc[2 * q + 1].y};
        f32x2v sum = (f32x2v){0.f, 0.f};
#pragma unroll
        for (int q = 0; q < 8; ++q) sum += *(const LAS f32x2v*)(red + q * 128 + 2 * c.lane);
        x.x += sum.x; x.y += sum.y; if (DRY) { asm volatile("" :: "v"(x.x), "v"(x.y)); } else *xp = pk2(x.x, x.y);
    }
}

constexpr int PH_PER_LAYER = 10, N_PHASES = DEPTH * PH_PER_LAYER + 2;
struct Args { const float* in[16]; float* out; unsigned char* ws; int ph_lo, ph_hi; };

__global__ void __launch_bounds__(NTHR, 2) fwd_kernel(Args args) {
    extern __shared__ __attribute__((aligned(16))) unsigned char lds_raw[];
#define MKCTX() Ctx c; { const int t_ = tid_now(); c.tid = t_; c.lane = t_ & 63; c.wave = __builtin_amdgcn_readfirstlane(t_ >> 6); c.bid = blockIdx.x; c.nblk = gridDim.x; c.lds = (float*)lds_raw; }
    volatile LAS unsigned* MISC = (volatile LAS unsigned*)((LAS unsigned char*)lds_raw + MISC_OFF);
    { const int t0_ = threadIdx.x;
      if (t0_ < 32) MISC[t0_] = 0u;
      if ((t0_ & 63) == 0) ((volatile LAS int*)(unsigned)WTAB_OFF)[(unsigned)__builtin_amdgcn_s_getreg((5 << 11) | 4) & 63u] = t0_ >> 6; }
    __syncthreads();
    unsigned char* ws = args.ws;
    XcdBarrier bar; bar.bar = (unsigned*)(ws + WS_CTL) + CW_BAR; bar.x = 0; bar.st = nullptr;
    const bool multi = (args.ph_hi - args.ph_lo) > 1;
    if (multi) bar = xcd_barrier_post((unsigned*)(ws + WS_CTL) + CW_BAR, MISC + 8);

#define WSPTRS() const __attribute__((address_space(4))) Args* ka = (const __attribute__((address_space(4))) Args*)__builtin_amdgcn_kernarg_segment_ptr(); asm volatile("" : "+s"(ka)); \
    unsigned char* wsl = ka->ws; const float* x = ka->in[0]; \
    float* ZF = (float*)(wsl + WS_ZF); int* EIDX = (int*)(wsl + WS_EIDX); float* GATE = (float*)(wsl + WS_GATE); float* VN = (float*)(wsl + WS_VN); \
    bf16* XN = (bf16*)(wsl + WS_XN); bf16* MIXN = (bf16*)(wsl + WS_MIXN); bf16* WT = (bf16*)(wsl + WS_W); bf16* ZB = (bf16*)(wsl + WS_ZB); \
    unsigned char* EU = wsl + WS_EU; unsigned char* EV = wsl + WS_EV; float* ES = (float*)(wsl + WS_ES); unsigned char* XN8 = wsl + WS_XN8; float* SH = (float*)(wsl + WS_SH); \
    int* AI = (int*)(wsl + WS_AI); float* SUK = (float*)(wsl + WS_SUK); unsigned long long* RSQ = (unsigned long long*)(wsl + WS_RSQ); unsigned long long* KN2 = (unsigned long long*)(wsl + WS_KN2); float* MIX = (float*)(wsl + WS_MIX); bf16* XB = (bf16*)(wsl + WS_XB); \
    LAS unsigned char* ldsp = (LAS unsigned char*)lds_raw; const int G = gridDim.x; \
    (void)x; (void)ZF; (void)EIDX; (void)GATE; (void)VN; (void)XN; (void)MIXN; (void)WT; (void)ZB; (void)EU; (void)EV; (void)ES; (void)XN8; (void)SH; (void)AI; (void)SUK; (void)RSQ; (void)KN2; (void)MIX; (void)XB; (void)ldsp; (void)G;
#ifndef PROBE_DUP
#define PROBE_DUP 0
#endif
#define DUP(flag, body) do { body; if (PROBE_DUP & (flag)) { body; } } while (0)
#define COMMA ,
#define RUN(k, body) do { const int k_ = (k); if (args.ph_lo <= k_ && k_ < args.ph_hi) { { MKCTX(); WSPTRS(); body; } if (k_ + 1 < args.ph_hi) xcd_barrier(bar); } } while (0)
    RUN(0, { { const WeightJob WJ0_{ka->in[2] COMMA ka->in[9] COMMA ka->in[11] COMMA ka->in[8] COMMA WT COMMA 0 COMMA WI_IN}; DUP(256, ph_prologue(c, WJ0_)); } ph_rmsnorm_bf16<false COMMA false>(c, x, ka->in[1], XN, nullptr, nullptr, RSQ, KN2); });
#define GEMM_PH(EpiT, Einit, Aptr, Bptr, NN) do { pg8::Gemm g_{Aptr, Bptr, T, NN, D}; pg8::StaticOrder S_; S_.init(T, NN, G, (int)blockIdx.x); \
        EpiT E_ Einit; pg8::gemm_phase<EpiT, pg8::StaticOrder, PG8_ALIGN, PG8_SP2>(ldsp, g_, S_, E_); } while (0)
#define LAYER(l) { \
        const int p0 = 1 + l * PH_PER_LAYER; \
        if (l > 0) RUN(p0 + 0, ph_rmsnorm_bf16<false COMMA true>(c, XB, ka->in[1] + (size_t)l * D, XN, nullptr, nullptr, RSQ, KN2)); \
        RUN(p0 + 1, DUP(8, GEMM_PH(EpiZ, {ZB COMMA ZF COMMA attn_body::C2 COMMA KN2}, XN, (WT + (size_t)l * WROWS_PER_LAYER * D), NIN_PAD))); \
        RUN(p0 + 2, { DUP(4, { const attn_body::AttnTensors AT_{(const attn_body::bf16*)ZB + NQ COMMA (const attn_body::bf16*)ZB + NK COMMA (const attn_body::bf16*)ZB + NV COMMA (attn_body::bf16*)MIXN COMMA ZF COMMA ka->in[3] + l * NH COMMA RSQ COMMA KN2}; const QuantJob QJ_{ka->in[13] COMMA ka->in[14] COMMA EU COMMA EV COMMA ES COMMA l}; const WeightJob WJ_{ka->in[2] COMMA ka->in[9] COMMA ka->in[11] COMMA ka->in[8] COMMA WT COMMA (l == 0 ? WI_IN : WI_L + WI_IN) COMMA (l == 0 ? WI_L + WI_IN : 2 * WI_L)}; \
            if ((G & 7) == 0) { attn_body::attn_phase_dyn((char*)lds_raw COMMA AT_ COMMA (unsigned*)(wsl + WS_CTL) + 20480 + 16 * l COMMA (int)blockIdx.x COMMA QJ_ COMMA WJ_); } else { { const int t_ = tid_now(); const int wv_ = __builtin_amdgcn_readfirstlane(t_ >> 6); for (int qu_ = (int)blockIdx.x; qu_ < QUANT_UNITS; qu_ += G) quant_unit(QJ_ COMMA qu_ COMMA wv_ COMMA t_ & 63); for (int wu_ = (int)blockIdx.x; wu_ < weight_units(WJ_); wu_ += G) weight_unit(WJ_ COMMA wu_ COMMA ldsp COMMA wv_ COMMA t_ & 63); __syncthreads(); } const attn_body::StaticOrder SA_(G COMMA (int)blockIdx.x); attn_body::attn_phase<attn_body::StaticOrder>((char*)lds_raw COMMA AT_ COMMA SA_); } }); \
            { MKCTX(); DUP(16, for (int u_ = c.bid; u_ < 2 * T / CHUNK; u_ += c.nblk) mixlocal_unit(c, u_, ZB, ka->in[5] + (size_t)l * 4 * CHUNK * CHUNK, ka->in[6] + l * 4 * CHUNK, ka->in[4] + l * 256, ka->in[7] + l * 3 * 256, ka->in[8] + (size_t)l * D, MIXN)); } }); \
        RUN(p0 + 3, GEMM_PH(EpiOut, {XB COMMA D COMMA (l == 0 ? (const void*)x : (const void*)XB) COMMA (l == 0 ? 0 : 1) COMMA RSQ}, MIXN, (WT + (size_t)l * WROWS_PER_LAYER * D) + (size_t)NIN_PAD * D, D)); \
        RUN(p0 + 4, DUP(1, ph_rmsnorm_bf16<true COMMA true>(c, XB, ka->in[10] + (size_t)l * D, XN, XN8, SH))); \
        if ((int)gridDim.x * 2 == (T / 256) * (2048 / 256)) RUN(p0 + 5, { GEMM_PH(pg8::EpiBf16<0>, {ZB COMMA 2048 COMMA nullptr COMMA 0 COMMA 0 COMMA 1.f}, XN, (WT + (size_t)l * WROWS_PER_LAYER * D) + (size_t)(NIN_PAD + D) * D, 2048); \
            pg8::StaticOrder SQ_; SQ_.init(T, 2048, G, (int)blockIdx.x); pg8::Unit u0_; pg8::Unit u1_; SQ_.next(0, u0_); SQ_.next(1, u1_); const int lt0_ = u0_.pm * 8 + u0_.pn; const int lt1_ = u1_.pm * 8 + u1_.pn; \
            asm volatile("s_waitcnt vmcnt(0)" ::: "memory"); __syncthreads(); \
            ph_topk1_mfma<true>(c, ZB, ka->in[12] + (size_t)l * 2 * NKEYS * DHALF, VN, (int*)MIX, lt0_, lt1_); \
            asm volatile("s_waitcnt vmcnt(0)" ::: "memory"); __syncthreads(); \
            ph_topk2<true COMMA true>(c, VN, (const int*)MIX, EIDX, GATE, AI, SUK, ES + l * NEXP, ES + (DEPTH + l) * NEXP, lt0_, lt1_); }); \
        if ((int)gridDim.x * 2 != (T / 256) * (2048 / 256)) RUN(p0 + 5, DUP(8, GEMM_PH(pg8::EpiBf16<0>, {ZB COMMA 2048 COMMA nullptr COMMA 0 COMMA 0 COMMA 1.f}, XN, (WT + (size_t)l * WROWS_PER_LAYER * D) + (size_t)(NIN_PAD + D) * D, 2048))); \
        if ((int)gridDim.x * 2 != (T / 256) * (2048 / 256)) RUN(p0 + 6, { DUP(2, ph_topk1_mfma<false>(c, ZB, ka->in[12] + (size_t)l * 2 * NKEYS * DHALF, VN, (int*)MIX)); \
            if (c.nblk * NWAVES * 4 == T * PH * 2 / 32) { asm volatile("s_waitcnt vmcnt(0)" ::: "memory"); __syncthreads(); ph_topk2<true>(c, VN, (const int*)MIX, EIDX, GATE, AI, SUK, ES + l * NEXP, ES + (DEPTH + l) * NEXP); } }); \
        if ((int)gridDim.x * 2 != (T / 256) * (2048 / 256) && (int)gridDim.x * NWAVES * 4 != T * PH * 2 / 32) RUN(p0 + 7, ph_topk2<false>(c, VN, (const int*)MIX, EIDX, GATE, AI, SUK, ES + l * NEXP, ES + (DEPTH + l) * NEXP)); \
        RUN(p0 + 8, if (PROBE_DUP & 64) ph_peer_u<true>(c, XN8, EIDX, AI, EU + (size_t)l * NEXP * D); ph_peer_u<false>(c, XN8, EIDX, AI, EU + (size_t)l * NEXP * D)); \
        RUN(p0 + 9, if (PROBE_DUP & 512) ph_peer_v<true>(c, EIDX, GATE, AI, SH, SUK, EV + (size_t)l * NEXP * D, XB); ph_peer_v<false>(c, EIDX, GATE, AI, SH, SUK, EV + (size_t)l * NEXP * D, XB)); \
    }
    LAYER(0)
    LAYER(1)
#undef LAYER
    RUN(1 + DEPTH * PH_PER_LAYER, ph_rmsnorm(c, XB, ka->in[15], ka->out));
#undef RUN
}

extern "C" void kernel_launch(void* const* d_in, const int* in_sizes, int n_in, void* d_out, int out_size, void* d_ws, size_t ws_size, hipStream_t stream) {
    static int grid = 0;
    if (grid == 0) {
        if (n_in != 16 || out_size != T * D || ws_size < WS_END) { fprintf(stderr, "kernel_launch: unexpected shapes (n_in %d out %d ws %zu)\n", n_in, out_size, ws_size); grid = -1; return; }
        int dev = 0, cus = 0, per_cu = 0;
        hipGetDevice(&dev); hipDeviceGetAttribute(&cus, hipDeviceAttributeMultiprocessorCount, dev);
        hipFuncSetAttribute((const void*)fwd_kernel, hipFuncAttributeMaxDynamicSharedMemorySize, LDS_BYTES);
        hipOccupancyMaxActiveBlocksPerMultiprocessor(&per_cu, (const void*)fwd_kernel, NTHR, LDS_BYTES);
        (void)hipGetLastError();
        if (per_cu < 1) { fprintf(stderr, "kernel_launch: occupancy query says %d\n", per_cu); }
        grid = cus;
    }
    if (grid < 0) return;
    hipMemsetAsync((char*)d_ws + WS_CTL, 0, CTL_ZERO_BYTES, stream);
    Args a{};
    for (int i = 0; i < 16; ++i) a.in[i] = (const float*)d_in[i];
    a.out = (float*)d_out; a.ws = (unsigned char*)d_ws;
    if (MK_N_LAUNCHES == 1) {
        a.ph_lo = 0; a.ph_hi = N_PHASES;
        hipLaunchKernelGGL(fwd_kernel, dim3(grid), dim3(NTHR), LDS_BYTES, stream, a);
    } else {
        for (int ph = 0; ph < N_PHASES; ++ph) { a.ph_lo = ph; a.ph_hi = ph + 1; hipLaunchKernelGGL(fwd_kernel, dim3(grid), dim3(NTHR), LDS_BYTES, stream, a); }
    }
}
```

```cpp
#include <hip/hip_runtime.h>
#include <cstdio>
#include <cstdint>

#ifndef MK_N_LAUNCHES
#define MK_N_LAUNCHES 1
#endif

constexpr int D = 1024, NB = 2, S = 8192, T = NB * S, DEPTH = 2;
constexpr int NH = 8, HD = 64, CHUNK = 128;
constexpr int IN_COLS = 2824;
constexpr int ZC = 3072, NQ = 0, NK = 512, NV = 1024, NGU = 1536, NGV = 1792, NCI = 2048, NCB = 2304, NCC = 2560, NF = 2816;
constexpr int PH = 8, NKEYS = 128, NEXP = 16384, TOPK = 16, DKEY = 256, DHALF = 128;
constexpr float EPS = 1e-6f;
constexpr int NTHR = 512, NWAVES = 8;

constexpr size_t MiB = 1u << 20;
constexpr size_t WS_CTL = 0, CTL_ZERO_BYTES = 96 * 1024;
constexpr size_t WS_F = 1 * MiB;
constexpr size_t WS_ZF = 1 * MiB + 512 * 1024;
constexpr size_t WS_EIDX = 2 * MiB;
constexpr size_t WS_GATE = 10 * MiB;
constexpr size_t WS_VN = 18 * MiB;
constexpr size_t WS_XN = 34 * MiB;
constexpr size_t WS_MIXN = 66 * MiB;
constexpr size_t WS_MIX = 98 * MiB;
constexpr size_t WS_XB = 162 * MiB;
constexpr size_t WS_ZB = 226 * MiB;
constexpr size_t WS_W = 322 * MiB;
constexpr size_t WS_EU = 346 * MiB;
constexpr size_t WS_EV = 378 * MiB;
constexpr size_t WS_XN8 = 412 * MiB;
constexpr size_t WS_SH = 430 * MiB;
constexpr size_t WS_SUK = 440 * MiB;
constexpr size_t WS_RSQ = 431 * MiB;
constexpr size_t WS_KN2 = 456 * MiB;
constexpr size_t WS_AI = 432 * MiB;
constexpr size_t WS_ES = 410 * MiB;
constexpr int NIN_PAD = 3072, WROWS_PER_LAYER = NIN_PAD + D + 2048;
constexpr size_t WS_END = 474 * MiB;
constexpr int CW_BAR = 4096;

constexpr int LDS_BYTES = 147456;
constexpr int MISC_OFF = 131072 + 320;

#define GAS __attribute__((address_space(1)))
#define LAS __attribute__((address_space(3)))
typedef GAS unsigned gu32;
#define RLX_AGENT __ATOMIC_RELAXED, __HIP_MEMORY_SCOPE_AGENT
constexpr int WTAB_OFF = MISC_OFF + 256;
__device__ __forceinline__ int tid_now() {
    const unsigned hw = (unsigned)__builtin_amdgcn_s_getreg((5 << 11) | 4) & 63u;
    const int w = __builtin_amdgcn_readfirstlane(((const volatile LAS int*)(unsigned)WTAB_OFF)[hw]);
    int lane; asm volatile("v_mbcnt_lo_u32_b32 %0, -1, 0\n\tv_mbcnt_hi_u32_b32 %0, -1, %0" : "=v"(lane));
    return w * 64 + lane;
}

#define XB_TMO      128
#define XB_XCNT(j)  (256  + 64 * (j))
#define XB_XSUB(j)  (1280 + 64 * (j))
#define XB_XGEN(j)  (2304 + 64 * (j))
#define XB_TOP      3328
#define XB_TOPGEN   3392
#define XCD_BAR_WORDS 3456
#define XB_SPIN_CAP (1u << 22)
__device__ __forceinline__ unsigned xb_ld(unsigned* p)              { return __hip_atomic_load(p, __ATOMIC_RELAXED, __HIP_MEMORY_SCOPE_AGENT); }
__device__ __forceinline__ unsigned xb_add(unsigned* p, unsigned v) { return __hip_atomic_fetch_add(p, v, __ATOMIC_RELAXED, __HIP_MEMORY_SCOPE_AGENT); }
__device__ __forceinline__ unsigned xb_xcc_id() { return (unsigned)__builtin_amdgcn_s_getreg((3 << 11) | 20) & 0xFu; }
#define XB_SPIN(cond, bar) do { unsigned _sp = 0; while (cond) { __builtin_amdgcn_s_sleep(1); \
    if ((++_sp & 255u) == 0u) { if (xb_ld(&(bar)[XB_TMO])) break; if (_sp > XB_SPIN_CAP) { atomicAdd(&(bar)[XB_TMO], 1u); break; } } } } while (0)
struct XcdBarrier { unsigned* bar; unsigned x; volatile LAS unsigned* st; };
__device__ __forceinline__ XcdBarrier xcd_barrier_post(unsigned* bar, volatile LAS unsigned* st) {
    XcdBarrier b; b.bar = bar; b.x = xb_xcc_id(); b.st = st;
    if (tid_now() == 0) (void)xb_add(&bar[XB_XCNT(b.x)], 1u);
    return b;
}
__device__ __forceinline__ void xcd_barrier_complete(unsigned* bar, unsigned x, unsigned& nloc, unsigned& nx) {
    const unsigned G = gridDim.x * gridDim.y * gridDim.z;
    unsigned sum, cnt, mine, sp = 0u;
    for (;;) {
        sum = 0u; cnt = 0u; mine = 0u;
#pragma unroll
        for (unsigned j = 0; j < 16; ++j) { const unsigned c = xb_ld(&bar[XB_XCNT(j)]); sum += c; cnt += (c > 0u) ? 1u : 0u; mine = (j == x) ? c : mine; }
        if (sum == G) break;
        __builtin_amdgcn_s_sleep(1);
        if ((++sp & 255u) == 0u) { if (xb_ld(&bar[XB_TMO])) break; if (sp > XB_SPIN_CAP) { atomicAdd(&bar[XB_TMO], 1u); break; } }
    }
    nloc = mine > 0u ? mine : 1u; nx = cnt > 0u ? cnt : 1u;
}
__device__ __forceinline__ void xcd_barrier(const XcdBarrier& b) {
    asm volatile("s_waitcnt vmcnt(0)" ::: "memory");
    __syncthreads();
    if (tid_now() == 0) {
        unsigned* bar = b.bar;
        __builtin_amdgcn_s_waitcnt(0);
        unsigned nloc = b.st[0], nx = b.st[1];
        if (nloc == 0u) { xcd_barrier_complete(bar, b.x, nloc, nx); b.st[0] = nloc; b.st[1] = nx; }
        const unsigned old = xb_add(&bar[XB_XSUB(b.x)], 1u);
        const unsigned gen = old / nloc;
        if (old + 1u == (gen + 1u) * nloc) {
            __builtin_amdgcn_fence(__ATOMIC_RELEASE, "agent");
            asm volatile("s_waitcnt vmcnt(0)" ::: "memory");
            const unsigned og = xb_add(&bar[XB_TOP], 1u);
            const unsigned tg = og / nx;
            if (og + 1u == (tg + 1u) * nx) xb_add(&bar[XB_TOPGEN], 1u);
            else XB_SPIN(xb_ld(&bar[XB_TOPGEN]) == tg, bar);
            __builtin_amdgcn_fence(__ATOMIC_ACQUIRE, "agent");
            xb_add(&bar[XB_XGEN(b.x)], 1u);
            asm volatile("s_waitcnt vmcnt(0)" ::: "memory");
        } else {
            XB_SPIN(xb_ld(&bar[XB_XGEN(b.x)]) == gen, bar);
            __builtin_amdgcn_fence(__ATOMIC_ACQUIRE, "agent");
            asm volatile("s_waitcnt vmcnt(0)" ::: "memory");
        }
    }
    __syncthreads();
}

namespace pg8 {
#define PG8_LAS __attribute__((address_space(3)))
typedef unsigned short bf16_t;
typedef short bf16x8 __attribute__((ext_vector_type(8)));
typedef float f32x4 __attribute__((ext_vector_type(4)));
typedef unsigned u32x4 __attribute__((ext_vector_type(4)));
constexpr int BM = 256, BK = 64, HALF = 128, HTB = HALF * BK * 2  , STAGE_BYTES = 8 * HTB, NXCD = 8, WGM = 8;

__host__ __device__ __forceinline__ int lds_byte(int r, int c) { const int st = (r >> 4) * 2 + (c >> 5), rr = r & 15, cc = c & 31, ob = rr * 64 + cc * 2; return st * 1024 + (ob ^ (((ob >> 9) & 1) << 5)); }
__host__ __device__ __forceinline__ void stage_rc(int b, int& R, int& C) { const int st = b / 1024, sb = b % 1024, swz = sb ^ (((sb >> 9) & 1) << 5); R = (st >> 1) * 16 + swz / 64; C = (st & 1) * 32 + (swz % 64) / 2; }
__host__ __device__ __forceinline__ int perm32(int rho) { const int n = rho >> 4, i = rho & 15; return 8 * (i >> 2) + 4 * n + (i & 3); }

struct Unit { int pm, pn; };
struct Gemm { const bf16_t* A; const bf16_t* Bt; int M, N, K; };

struct StaticOrder {
    int nM, nN, nwg, G, c;
    __host__ __device__ __forceinline__ void init(int M, int N, int G_, int c_) { nM = M / BM; nN = N / BM; nwg = nM * nN; G = G_; c = c_; }
    __host__ __device__ __forceinline__ bool next(int i, Unit& u) const {
        const long L = (long)i * G + c; if (L >= nwg) return false;
        int wgid = (int)L; { const int q = nwg / NXCD, r = nwg % NXCD, xcd = wgid % NXCD, off = wgid / NXCD; wgid = (xcd < r ? xcd * (q + 1) : r * (q + 1) + (xcd - r) * q) + off; }
        const int nig = WGM * nN, gid = wgid / nig, fm = gid * WGM, gsz = (nM - fm) < WGM ? (nM - fm) : WGM;
        u.pm = fm + ((wgid % nig) % gsz); u.pn = (wgid % nig) / gsz; return true;
    }
    __device__ __forceinline__ void a_ready(const Unit&) const {}
    __device__ __forceinline__ void done(const Unit&) const {}
};

__device__ __forceinline__ unsigned cvt_pk_bf16(float lo, float hi) { unsigned r; asm volatile("v_cvt_pk_bf16_f32 %0, %1, %2" : "=v"(r) : "v"(lo), "v"(hi)); return r; }
typedef float f32x2 __attribute__((ext_vector_type(2)));
__device__ __forceinline__ f32x2 gelu_pk(f32x2 v) {
    const f32x2 av = __builtin_elementwise_abs(v), d = av * 0.2316418882f + 1.0f;
    f32x2 t; t.x = __builtin_amdgcn_rcpf(d.x); t.y = __builtin_amdgcn_rcpf(d.y);
    f32x2 q = t * 0.5307027145f + (-0.7265760135f); q = q * t + 0.7107068705f; q = q * t + (-0.142248368f); q = q * t + 0.127414796f; q = q * t;
    const f32x2 s = (v * v) * (-0.72134752044f);
    f32x2 e; e.x = __builtin_amdgcn_exp2f(s.x); e.y = __builtin_amdgcn_exp2f(s.y);
    const f32x2 m = v * (q * e), r = v - m;
    f32x2 o; o.x = v.x < 0.f ? m.x : r.x; o.y = v.y < 0.f ? m.y : r.y; return o;
}

template <int ACT  > struct EpiBf16 {
    static constexpr bool PERM = true, AFTER_DRAIN = false; static constexpr int MIDK = 0; static_assert(ACT == 0 || ACT == 1, "EpiBf16: ACT is 0 (none) or 1 (gelu_pk)");
    bf16_t* O; int ldc; const float* bias; int split_cols; size_t split_stride; float scale0;
    __device__ __forceinline__ void operator()(const f32x4 (&acc)[2][2][4][2], const Unit& u, int wr, int wc, int fr, int fq) const {
        const int row0 = u.pm * BM + wr * 64 + fr; int colt = u.pn * BM; bf16_t* base = O;
        float sc = 1.f; if (split_cols) { const int t = colt / split_cols; base += (size_t)t * split_stride; colt -= t * split_cols; if (t == 0) sc = scale0; }
        const int col0 = colt + wc * 32 + 8 * fq, bcol0 = u.pn * BM + wc * 32 + 8 * fq;
        f32x4 bv[2][2];
#pragma unroll
        for (int bj = 0; bj < 2; ++bj)
#pragma unroll
            for (int n = 0; n < 2; ++n) bv[bj][n] = bias ? *(const f32x4*)(bias + bcol0 + bj * HALF + 4 * n) : (f32x4){0.f, 0.f, 0.f, 0.f};
#pragma unroll
        for (int ai = 0; ai < 2; ++ai)
#pragma unroll
            for (int m = 0; m < 4; ++m) { bf16_t* rowp = base + (size_t)(row0 + ai * HALF + m * 16) * ldc + col0;
#pragma unroll
                for (int bj = 0; bj < 2; ++bj) { f32x4 v0 = acc[ai][bj][m][0] + bv[bj][0], v1 = acc[ai][bj][m][1] + bv[bj][1];
                    if (ACT == 1) { f32x2 a = gelu_pk((f32x2){v0[0], v0[1]}), b = gelu_pk((f32x2){v0[2], v0[3]}), c = gelu_pk((f32x2){v1[0], v1[1]}), d = gelu_pk((f32x2){v1[2], v1[3]});
                        v0 = (f32x4){a.x, a.y, b.x, b.y}; v1 = (f32x4){c.x, c.y, d.x, d.y}; }
                    v0 = v0 * sc; v1 = v1 * sc; u32x4 w; w.x = cvt_pk_bf16(v0[0], v0[1]); w.y = cvt_pk_bf16(v0[2], v0[3]); w.z = cvt_pk_bf16(v1[0], v1[1]); w.w = cvt_pk_bf16(v1[2], v1[3]);
                    *(u32x4*)(rowp + bj * HALF) = w; } }
    }
};

struct PanelStats {
    unsigned* xbuf;
    unsigned* cnt;
    unsigned* tmo;
    int ntn; float eps;
    unsigned code;
    __device__ __forceinline__ bool run(const f32x4 (&v)[2][2][4][2], const Unit& u, int wr, int wc, int fr, int fq, PG8_LAS unsigned char* lds, int wid, int lane) const {
        typedef float f32x2v __attribute__((ext_vector_type(2)));
        PG8_LAS f32x2v* P = (PG8_LAS f32x2v*)lds;
        PG8_LAS f32x2v* S = (PG8_LAS f32x2v*)(lds + 8192);
        PG8_LAS unsigned* flag = (PG8_LAS unsigned*)(lds + 8192 + 2048);
#pragma unroll
        for (int ai = 0; ai < 2; ++ai)
#pragma unroll
            for (int m = 0; m < 4; ++m) {
                float s = 0.f;
#pragma unroll
                for (int bj = 0; bj < 2; ++bj)
#pragma unroll
                    for (int n = 0; n < 2; ++n) { const f32x4 x = v[ai][bj][m][n]; s += (x[0] + x[1]) + (x[2] + x[3]); }
                s += __shfl_xor(s, 16); s += __shfl_xor(s, 32);
                const float mw = s * (1.0f / 64.0f); float q = 0.f;
#pragma unroll
                for (int bj = 0; bj < 2; ++bj)
#pragma unroll
                    for (int n = 0; n < 2; ++n) { const f32x4 d = v[ai][bj][m][n] - mw; q += (d[0] * d[0] + d[1] * d[1]) + (d[2] * d[2] + d[3] * d[3]); }
                q += __shfl_xor(q, 16); q += __shfl_xor(q, 32);
                if (fq == 0) P[(ai * HALF + wr * 64 + m * 16 + fr) * 4 + wc] = (f32x2v){mw, q};
            }
        asm volatile("s_waitcnt lgkmcnt(0)" ::: "memory"); __builtin_amdgcn_s_barrier(); asm volatile("" ::: "memory");
#if defined(BROKEN_EXCHANGE_NO_WAIT)
#warning BROKEN CONTROL BUILD: the row-statistics exchange does not wait; results are wrong by design
        if (blockIdx.x >= 64) { const long long t0_ = clock64(); while (clock64() - t0_ < 60000) __builtin_amdgcn_s_sleep(8); }
#endif
        const int row = wid * 32 + (lane & 31);
        if (lane < 32) {
            const f32x2v a = P[row * 4 + 0], b = P[row * 4 + 1], c = P[row * 4 + 2], d = P[row * 4 + 3];
            const float mt = (a.x + b.x + c.x + d.x) * 0.25f;
            const float da = a.x - mt, db = b.x - mt, dc = c.x - mt, dd = d.x - mt;
            const float m2 = (a.y + b.y) + (c.y + d.y) + 64.0f * ((da * da + db * db) + (dc * dc + dd * dd));
            unsigned long long* slot = (unsigned long long*)xbuf + ((size_t)(u.pm * BM + row) * 4 + u.pn);
            __hip_atomic_store(slot, ((unsigned long long)__float_as_uint(m2) << 32) | __float_as_uint(mt), __ATOMIC_RELAXED, __HIP_MEMORY_SCOPE_AGENT);
        }
        asm volatile("s_waitcnt vmcnt(0)" ::: "memory");
        if (lane == 0) __hip_atomic_fetch_add(cnt + 64 * u.pm, 1u, __ATOMIC_RELAXED, __HIP_MEMORY_SCOPE_AGENT);
        if (wid == 0) {
            bool dead = false; const unsigned long long t0 = __builtin_amdgcn_s_memrealtime(); const unsigned want = 8u * (unsigned)ntn;
            for (;;) {
#if defined(BROKEN_EXCHANGE_NO_WAIT)
                break;
#endif
                if ((unsigned)__builtin_amdgcn_readfirstlane(__hip_atomic_load(cnt + 64 * u.pm, __ATOMIC_RELAXED, __HIP_MEMORY_SCOPE_AGENT)) >= want) break;
                if (__builtin_amdgcn_s_memrealtime() - t0 > 2000000ull) {
                    if (lane == 0) { unsigned expect = 0u; __hip_atomic_compare_exchange_strong(tmo + 1, &expect, code | (unsigned)(u.pm & 0xff), __ATOMIC_RELAXED, __ATOMIC_RELAXED, __HIP_MEMORY_SCOPE_AGENT);
                                     __hip_atomic_store(tmo, 1u, __ATOMIC_RELAXED, __HIP_MEMORY_SCOPE_AGENT); }
                    dead = true; break; }
                __builtin_amdgcn_s_sleep(2);
            }
            __builtin_amdgcn_fence(__ATOMIC_ACQUIRE, "agent");
            if (lane == 0) flag[0] = dead ? 1u : 0u;
        }
        asm volatile("s_waitcnt vmcnt(0) lgkmcnt(0)" ::: "memory"); __builtin_amdgcn_s_barrier(); asm volatile("" ::: "memory");
        const bool bad = flag[0] != 0u;
        if (lane < 32) {
            const unsigned long long* slot = (const unsigned long long*)xbuf + (size_t)(u.pm * BM + row) * 4; float mt[4], m2[4]; float ms = 0.f;
#pragma unroll
            for (int t = 0; t < 4; ++t) { if (t < ntn) { const unsigned long long w = __hip_atomic_load(slot + t, __ATOMIC_RELAXED, __HIP_MEMORY_SCOPE_AGENT); mt[t] = __uint_as_float((unsigned)w); m2[t] = __uint_as_float((unsigned)(w >> 32)); } else { mt[t] = 0.f; m2[t] = 0.f; } ms += mt[t]; }
            const float mean = ms / (float)ntn; float q = 0.f;
#pragma unroll
            for (int t = 0; t < 4; ++t) if (t < ntn) { const float dm = mt[t] - mean; q += m2[t] + 256.0f * dm * dm; }
            S[row] = (f32x2v){mean, 1.0f / sqrtf(q / (256.0f * (float)ntn) + eps)};
        }
        asm volatile("s_waitcnt lgkmcnt(0)" ::: "memory"); __builtin_amdgcn_s_barrier(); asm volatile("" ::: "memory");
        return bad;
    }
};
struct EpiLnRes {
    static constexpr bool PERM = false, AFTER_DRAIN = true;
    const float* base; float* out; int ldc; const float* bias; PanelStats st; unsigned poison;
    __device__ __forceinline__ void fused(f32x4 (&acc)[2][2][4][2], const Unit& u, int wr, int wc, int fr, int fq, PG8_LAS unsigned char* lds, int wid, int lane) const {
        typedef float f32x2v __attribute__((ext_vector_type(2)));
        const PG8_LAS f32x2v* S = (const PG8_LAS f32x2v*)(lds + 8192);
        const int col0 = u.pn * BM + wc * 32 + 4 * fq;
#pragma unroll
        for (int bj = 0; bj < 2; ++bj)
#pragma unroll
            for (int n = 0; n < 2; ++n) { const f32x4 bv = bias ? *(const f32x4*)(bias + col0 + bj * HALF + n * 16) : (f32x4){0.f, 0.f, 0.f, 0.f};
#pragma unroll
                for (int ai = 0; ai < 2; ++ai)
#pragma unroll
                    for (int m = 0; m < 4; ++m) acc[ai][bj][m][n] += bv; }
        f32x4 pre[4][2][2];
#pragma unroll
        for (int m = 0; m < 4; ++m) { const size_t off = (size_t)(u.pm * BM + wr * 64 + m * 16 + fr) * ldc + col0;
#pragma unroll
            for (int bj = 0; bj < 2; ++bj)
#pragma unroll
                for (int n = 0; n < 2; ++n) pre[m][bj][n] = *(const f32x4*)(base + off + bj * HALF + n * 16); }
        const bool bad = st.run(acc, u, wr, wc, fr, fq, lds, wid, lane) || poison != 0u;
        const float qnan = __builtin_nanf("");
#pragma unroll
        for (int ai = 0; ai < 2; ++ai)
#pragma unroll
            for (int m = 0; m < 4; ++m) { const int r = ai * HALF + wr * 64 + m * 16 + fr; const f32x2v sr = S[r]; const size_t off = (size_t)(u.pm * BM + r) * ldc + col0;
#pragma unroll
                for (int bj = 0; bj < 2; ++bj)
#pragma unroll
                    for (int n = 0; n < 2; ++n) { const f32x4 bs = ai == 0 ? pre[m][bj][n] : *(const f32x4*)(base + off + bj * HALF + n * 16); f32x4 o = bs + (acc[ai][bj][m][n] - sr.x) * sr.y;
                        if (bad) o = (f32x4){qnan, qnan, qnan, qnan}; *(f32x4*)(out + off + bj * HALF + n * 16) = o; }
                if (m & 1) asm volatile("" ::: "memory"); }
    }
};
struct EpiLnResLn {
    static constexpr bool PERM = false, AFTER_DRAIN = true;
    const float* base; float* out; bf16_t* xn; int ldc; const float* bias; PanelStats st1, st2; unsigned poison;
    __device__ __forceinline__ void fused(f32x4 (&acc)[2][2][4][2], const Unit& u, int wr, int wc, int fr, int fq, PG8_LAS unsigned char* lds, int wid, int lane) const {
        typedef float f32x2v __attribute__((ext_vector_type(2))); typedef unsigned u32x2v __attribute__((ext_vector_type(2)));
        const PG8_LAS f32x2v* S = (const PG8_LAS f32x2v*)(lds + 8192);
        const int col0 = u.pn * BM + wc * 32 + 4 * fq;
#pragma unroll
        for (int bj = 0; bj < 2; ++bj)
#pragma unroll
            for (int n = 0; n < 2; ++n) { const f32x4 bv = bias ? *(const f32x4*)(bias + col0 + bj * HALF + n * 16) : (f32x4){0.f, 0.f, 0.f, 0.f};
#pragma unroll
                for (int ai = 0; ai < 2; ++ai)
#pragma unroll
                    for (int m = 0; m < 4; ++m) acc[ai][bj][m][n] += bv; }
        bool bad = st1.run(acc, u, wr, wc, fr, fq, lds, wid, lane) || poison != 0u;
        const float qnan = __builtin_nanf("");
#pragma unroll
        for (int ai = 0; ai < 2; ++ai)
#pragma unroll
            for (int m = 0; m < 4; ++m) { const int r = ai * HALF + wr * 64 + m * 16 + fr; const f32x2v sr = S[r]; const size_t off = (size_t)(u.pm * BM + r) * ldc + col0;
#pragma unroll
                for (int bj = 0; bj < 2; ++bj)
#pragma unroll
                    for (int n = 0; n < 2; ++n) { const f32x4 bs = *(const f32x4*)(base + off + bj * HALF + n * 16); acc[ai][bj][m][n] = bs + (acc[ai][bj][m][n] - sr.x) * sr.y; }
                asm volatile("" : "+v"(acc[ai][0][m][0]), "+v"(acc[ai][0][m][1]), "+v"(acc[ai][1][m][0]), "+v"(acc[ai][1][m][1]));
                if (m & 1) asm volatile("" ::: "memory"); }
        const bool bad1 = bad;
        bad = st2.run(acc, u, wr, wc, fr, fq, lds, wid, lane) || bad;
#pragma unroll
        for (int ai = 0; ai < 2; ++ai)
#pragma unroll
            for (int m = 0; m < 4; ++m) { const int r = ai * HALF + wr * 64 + m * 16 + fr; const f32x2v sr = S[r]; const size_t off = (size_t)(u.pm * BM + r) * ldc + col0;
#pragma unroll
                for (int bj = 0; bj < 2; ++bj)
#pragma unroll
                    for (int n = 0; n < 2; ++n) { const f32x4 x1 = acc[ai][bj][m][n]; *(f32x4*)(out + off + bj * HALF + n * 16) = bad1 ? (f32x4){qnan, qnan, qnan, qnan} : x1;
                        const f32x4 o = (x1 - sr.x) * sr.y; u32x2v w; w.x = cvt_pk_bf16(o[0], o[1]); w.y = cvt_pk_bf16(o[2], o[3]);
                        if (bad) { w.x = 0x7fc07fc0u; w.y = 0x7fc07fc0u; } *(u32x2v*)(xn + off + bj * HALF + n * 16) = w; }
                asm volatile("" ::: "memory"); }
    }
};

template <class Epi, class Sched, bool ALIGN_EPI = false, bool SP2 = false>
__device__ __forceinline__ void gemm_phase(PG8_LAS unsigned char* lds, const Gemm g, const Sched& S, const Epi& E) {
    const int tid_ = tid_now();
    const int tid = tid_, wid = __builtin_amdgcn_readfirstlane(tid >> 6), lane = tid & 63, wr = wid >> 2, wc = wid & 3, fr = lane & 15, fq = lane >> 4;
    const int K = g.K, nt = K / BK;
    unsigned voffA[2], voffB[2];
#pragma unroll
    for (int i = 0; i < 2; ++i) { int R, C; stage_rc(tid * 16 + i * 8192, R, C); const int Rb = Epi::PERM ? ((R & ~31) + perm32(R & 31)) : R;
        voffA[i] = (unsigned)(R * K + C) * 2u; voffB[i] = (unsigned)(Rb * K + C) * 2u; }
    const size_t kstep = (size_t)(BK * 2);
    const size_t hstep = (size_t)HALF * K * 2;
    const size_t tstep = 2 * hstep;
    const unsigned ldsw = (unsigned)wid * 1024u;
    const int aoff = lds_byte(wr * 64 + fr, fq * 8), boff = lds_byte(wc * 32 + fr, fq * 8);
#define PG8_SA(b, h) (((b) * 2 + (h)) * HTB)
#define PG8_SB(b, h) ((4 + (b) * 2 + (h)) * HTB)
#define PG8_STAGE(bufoff, gbase, voff) do { _Pragma("unroll") for (int _i = 0; _i < 2; ++_i) \
        __builtin_amdgcn_global_load_lds((const unsigned*)((const char*)(gbase) + (voff)[_i]), (PG8_LAS unsigned*)(lds + (bufoff) + ldsw + _i * 8192), 16, 0, 0); } while (0)
#define PG8_LDA(dst, b, h) do { _Pragma("unroll") for (int m = 0; m < 4; ++m) _Pragma("unroll") for (int k = 0; k < 2; ++k) dst[m][k] = *(const PG8_LAS bf16x8*)(lds + PG8_SA(b, h) + aoff + m * 2048 + k * 1024); } while (0)
#define PG8_LDB(dst, b, h) do { _Pragma("unroll") for (int n = 0; n < 2; ++n) _Pragma("unroll") for (int k = 0; k < 2; ++k) dst[n][k] = *(const PG8_LAS bf16x8*)(lds + PG8_SB(b, h) + boff + n * 2048 + k * 1024); } while (0)
#define PG8_MMA(ai, bj, At, Bt) do { __builtin_amdgcn_s_setprio(1); _Pragma("unroll") for (int m = 0; m < 4; ++m) _Pragma("unroll") for (int n = 0; n < 2; ++n) _Pragma("unroll") for (int k = 0; k < 2; ++k) \
        acc[ai][bj][m][n] = __builtin_amdgcn_mfma_f32_16x16x32_bf16(Bt[n][k], At[m][k], acc[ai][bj][m][n], 0, 0, 0); __builtin_amdgcn_s_setprio(0); } while (0)
#define PG8_WAIT_V(n) asm volatile("s_waitcnt vmcnt(" #n ")" ::: "memory")
#define PG8_WAIT_L(n) asm volatile("s_waitcnt lgkmcnt(" #n ")" ::: "memory")
#define PG8_BAR __builtin_amdgcn_s_barrier()
#define PG8_SCHED __builtin_amdgcn_sched_barrier(0)
    Unit cur, nxt; int ui = 0;
    if (!S.next(0, cur)) return;
    f32x4 acc[2][2][4][2];
#pragma unroll
    for (int a = 0; a < 2; ++a)
#pragma unroll
        for (int b = 0; b < 2; ++b)
#pragma unroll
            for (int m = 0; m < 4; ++m)
#pragma unroll
                for (int n = 0; n < 2; ++n) acc[a][b][m][n] = (f32x4){0.f, 0.f, 0.f, 0.f};
    bf16x8 At[4][2], B0[2][2], B1[2][2];
    const char* cA = (const char*)g.A + (size_t)cur.pm * tstep; const char* cB = (const char*)g.Bt + (size_t)cur.pn * tstep;
    S.a_ready(cur);
    if constexpr (SP2) {
        PG8_STAGE(PG8_SB(0, 0), cB, voffB); PG8_STAGE(PG8_SB(0, 1), cB + hstep, voffB); PG8_STAGE(PG8_SA(0, 0), cA, voffA); PG8_STAGE(PG8_SA(0, 1), cA + hstep, voffA);
        if (wr == 1) PG8_BAR;
        PG8_WAIT_V(2); PG8_BAR;
        PG8_STAGE(PG8_SB(1, 0), cB + kstep, voffB); PG8_STAGE(PG8_SA(1, 0), cA + kstep, voffA); PG8_STAGE(PG8_SB(1, 1), cB + hstep + kstep, voffB);
        PG8_WAIT_V(6); PG8_BAR;
    } else {
        PG8_STAGE(PG8_SB(0, 0), cB, voffB); PG8_STAGE(PG8_SA(0, 0), cA, voffA); PG8_STAGE(PG8_SB(0, 1), cB + hstep, voffB); PG8_STAGE(PG8_SA(0, 1), cA + hstep, voffA);
        if (wr == 1) PG8_BAR;
        PG8_WAIT_V(4); PG8_BAR;
        PG8_STAGE(PG8_SB(1, 0), cB + kstep, voffB); PG8_STAGE(PG8_SA(1, 0), cA + kstep, voffA); PG8_STAGE(PG8_SB(1, 1), cB + hstep + kstep, voffB);
        PG8_WAIT_V(6); PG8_BAR;
    }
    for (;;) {
        const bool has_next = S.next(ui + 1, nxt);
        const char* nA = has_next ? (const char*)g.A + (size_t)nxt.pm * tstep : cA; const char* nB = has_next ? (const char*)g.Bt + (size_t)nxt.pn * tstep : cB;
        for (int t = 0; t < nt; t += 2) {
            const bool last = (t == nt - 2);
            const char* a1 = cA + (size_t)(t + 1) * kstep;
            const char* a2 = last ? nA : cA + (size_t)(t + 2) * kstep; const char* b2 = last ? nB : cB + (size_t)(t + 2) * kstep;
            const char* a3 = a2 + kstep; const char* b3 = b2 + kstep;
            if (last && has_next) S.a_ready(nxt);
            if constexpr (SP2) {
            PG8_LDB(B0, 0, 0); PG8_LDB(B1, 0, 1); PG8_SCHED; PG8_LDA(At, 0, 0); PG8_STAGE(PG8_SA(1, 1), a1 + hstep, voffA);
            PG8_WAIT_V(8); PG8_WAIT_L(0); PG8_BAR; PG8_MMA(0, 0, At, B0); PG8_MMA(0, 1, At, B1); PG8_BAR; PG8_SCHED;
            PG8_LDA(At, 0, 1); PG8_STAGE(PG8_SB(0, 0), b2, voffB); PG8_STAGE(PG8_SB(0, 1), b2 + hstep, voffB); PG8_STAGE(PG8_SA(0, 0), a2, voffA);
            PG8_WAIT_V(8); PG8_WAIT_L(0); PG8_BAR; PG8_MMA(1, 0, At, B0); PG8_MMA(1, 1, At, B1); PG8_BAR; PG8_SCHED;
            PG8_LDB(B0, 1, 0); PG8_LDB(B1, 1, 1); PG8_SCHED; PG8_LDA(At, 1, 0); PG8_STAGE(PG8_SA(0, 1), a2 + hstep, voffA);
            PG8_WAIT_V(8); PG8_WAIT_L(0); PG8_BAR; PG8_MMA(0, 0, At, B0); PG8_MMA(0, 1, At, B1); PG8_BAR; PG8_SCHED;
            PG8_LDA(At, 1, 1); PG8_STAGE(PG8_SB(1, 0), b3, voffB); PG8_STAGE(PG8_SB(1, 1), b3 + hstep, voffB); PG8_STAGE(PG8_SA(1, 0), a3, voffA);
            PG8_WAIT_V(8); PG8_WAIT_L(0); PG8_BAR; PG8_MMA(1, 0, At, B0); PG8_MMA(1, 1, At, B1); PG8_BAR; PG8_SCHED;
            } else {
            PG8_LDB(B0, 0, 0); PG8_SCHED; PG8_LDA(At, 0, 0); PG8_STAGE(PG8_SA(1, 1), a1 + hstep, voffA);
            PG8_WAIT_L(8); PG8_BAR; PG8_WAIT_L(0); PG8_MMA(0, 0, At, B0); PG8_BAR; PG8_SCHED;
            PG8_LDB(B1, 0, 1); PG8_STAGE(PG8_SB(0, 0), b2, voffB);
            PG8_BAR; PG8_WAIT_L(0); PG8_MMA(0, 1, At, B1); PG8_BAR;
            PG8_LDA(At, 0, 1); PG8_STAGE(PG8_SA(0, 0), a2, voffA);
            PG8_BAR; PG8_WAIT_L(0); PG8_MMA(1, 0, At, B0); PG8_BAR; PG8_SCHED;
            PG8_STAGE(PG8_SB(0, 1), b2 + hstep, voffB);
            PG8_WAIT_V(6); PG8_BAR; PG8_MMA(1, 1, At, B1); PG8_BAR;
            PG8_LDB(B0, 1, 0); PG8_SCHED; PG8_LDA(At, 1, 0); PG8_STAGE(PG8_SA(0, 1), a2 + hstep, voffA);
            PG8_WAIT_L(8); PG8_BAR; PG8_WAIT_L(0); PG8_MMA(0, 0, At, B0); PG8_BAR; PG8_SCHED;
            PG8_LDB(B1, 1, 1); PG8_STAGE(PG8_SB(1, 0), b3, voffB);
            PG8_BAR; PG8_WAIT_L(0); PG8_MMA(0, 1, At, B1); PG8_BAR;
            PG8_LDA(At, 1, 1); PG8_STAGE(PG8_SA(1, 0), a3, voffA);
            PG8_BAR; PG8_WAIT_L(0); PG8_MMA(1, 0, At, B0); PG8_BAR; PG8_SCHED;
            PG8_STAGE(PG8_SB(1, 1), b3 + hstep, voffB);
            PG8_WAIT_V(6); PG8_BAR; PG8_MMA(1, 1, At, B1); PG8_BAR;
            }
            if constexpr (Epi::MIDK > 0) { if (t + 2 == Epi::MIDK) E.midscale(acc, cur, wr, fr); }
        }
        if constexpr (ALIGN_EPI) { if (wr == 0) PG8_BAR; }
        if constexpr (!Epi::AFTER_DRAIN) { E(acc, cur, wr, wc, fr, fq); S.done(cur); }
        if (!has_next) break;
#pragma unroll
        for (int a = 0; a < 2; ++a)
#pragma unroll
            for (int b = 0; b < 2; ++b)
#pragma unroll
                for (int m = 0; m < 4; ++m)
#pragma unroll
                    for (int n = 0; n < 2; ++n) acc[a][b][m][n] = (f32x4){0.f, 0.f, 0.f, 0.f};
        cur = nxt; cA = nA; cB = nB; ++ui;
        if constexpr (ALIGN_EPI) { if (wr == 1) PG8_BAR; }
    }
    PG8_WAIT_V(0);
    if constexpr (!ALIGN_EPI) { if (wr == 0) PG8_BAR; }
    PG8_BAR;
    if constexpr (Epi::AFTER_DRAIN) { E.fused(acc, cur, wr, wc, fr, fq, lds, wid, lane); S.done(cur); }
#undef PG8_SA
#undef PG8_SB
#undef PG8_STAGE
#undef PG8_LDA
#undef PG8_LDB
#undef PG8_MMA
#undef PG8_WAIT_V
#undef PG8_WAIT_L
#undef PG8_BAR
#undef PG8_SCHED
}
}

#ifndef PG8_SP2
#define PG8_SP2 true
#endif
#ifndef PG8_ALIGN
#define PG8_ALIGN true
#endif

typedef unsigned short bf16;
typedef float pk_f32x2 __attribute__((ext_vector_type(2))); typedef __bf16 pk_bf16x2 __attribute__((ext_vector_type(2)));
__device__ __forceinline__ unsigned pk2(float lo, float hi) { pk_f32x2 v = {lo, hi}; pk_bf16x2 b = __builtin_convertvector(v, pk_bf16x2); return __builtin_bit_cast(unsigned, b); }
__device__ __forceinline__ unsigned f2bf(float f) { return pk2(f, 0.f) & 0xffffu; }
__device__ __forceinline__ unsigned pack4_i8(float a, float b, float c, float d, float inv) {
    const unsigned fa = __float_as_uint(__builtin_fmaf(a, inv, 12582912.f)), fb = __float_as_uint(__builtin_fmaf(b, inv, 12582912.f));
    const unsigned fc = __float_as_uint(__builtin_fmaf(c, inv, 12582912.f)), fd = __float_as_uint(__builtin_fmaf(d, inv, 12582912.f));
    return __builtin_amdgcn_perm(fb, fa, 0x0c0c0400u) | __builtin_amdgcn_perm(fd, fc, 0x04000c0cu);
}
__device__ __forceinline__ float bf_lo(unsigned u) { return __builtin_bit_cast(float, u << 16); }
__device__ __forceinline__ float bf_hi(unsigned u) { return __builtin_bit_cast(float, u & 0xffff0000u); }

struct EpiZ {
    static constexpr bool PERM = true, AFTER_DRAIN = false; static constexpr int MIDK = 0;
    bf16* ZB; float* ZF; float qscale; unsigned long long* KN2;
    __device__ __forceinline__ void operator()(const pg8::f32x4 (&acc)[2][2][4][2], const pg8::Unit& u, int wr, int wc, int fr, int fq) const {
        if (u.pn == 11) {
            if (wc == 0 && fq == 0) {
#pragma unroll
                for (int ai = 0; ai < 2; ++ai)
#pragma unroll
                    for (int m = 0; m < 4; ++m) { const int row = u.pm * 256 + ai * 128 + wr * 64 + m * 16 + fr; float* zp = ZF + (size_t)(row >> 13) * NH * S + (row & (S - 1));
#pragma unroll
                        for (int n = 0; n < 2; ++n)
#pragma unroll
                            for (int j = 0; j < 4; ++j) zp[(size_t)(4 * n + j) * S] = acc[ai][0][m][n][j]; }
            }
            return;
        }
        const float sc = (u.pn < 2) ? qscale : 1.f;
#pragma unroll
        for (int ai = 0; ai < 2; ++ai)
#pragma unroll
            for (int m = 0; m < 4; ++m) { bf16* rowp = ZB + (size_t)(u.pm * 256 + ai * 128 + wr * 64 + m * 16 + fr) * ZC + u.pn * 256 + wc * 32 + 8 * fq;
#pragma unroll
                for (int bj = 0; bj < 2; ++bj) { const pg8::f32x4 v0 = acc[ai][bj][m][0] * sc, v1 = acc[ai][bj][m][1] * sc;
                    pg8::u32x4 w; w.x = pg8::cvt_pk_bf16(v0[0], v0[1]); w.y = pg8::cvt_pk_bf16(v0[2], v0[3]); w.z = pg8::cvt_pk_bf16(v1[0], v1[1]); w.w = pg8::cvt_pk_bf16(v1[2], v1[3]);
                    *(pg8::u32x4*)(rowp + bj * 128) = w;
                    if (u.pn == 2 || u.pn == 3) {
                        float sq = 0.f;
#pragma unroll
                        for (int j = 0; j < 4; ++j) { const float lo_ = __uint_as_float(w[j] << 16), hi_ = __uint_as_float(w[j] & 0xffff0000u); sq += lo_ * lo_ + hi_ * hi_; }
                        sq += __shfl_xor(sq, 16); sq += __shfl_xor(sq, 32);
                        const int row = u.pm * 256 + ai * 128 + wr * 64 + m * 16 + fr, hd = (u.pn - 2) * 4 + 2 * bj + (wc >> 1);
                        if (fq == 0) atomicAdd(KN2 + ((size_t)((row >> 13) * NH + hd) * S + (row & (S - 1))), (unsigned long long)(sq * 1048576.f));
                    } } }
    }
};

struct EpiOut {
    static constexpr bool PERM = false, AFTER_DRAIN = false; static constexpr int MIDK = 8;
    bf16* C; int ldc; const void* R; int r_bf16; const unsigned long long* rsq;
    __device__ __forceinline__ void midscale(pg8::f32x4 (&acc)[2][2][4][2], const pg8::Unit& u, int wr, int fr) const {
#pragma unroll
        for (int ai = 0; ai < 2; ++ai)
#pragma unroll
            for (int m = 0; m < 4; ++m) { const float sc = rsqrtf((float)rsq[u.pm * 256 + ai * 128 + wr * 64 + m * 16 + fr] * (1.f / (512.f * 16777216.f)) + 1e-6f);
#pragma unroll
                for (int bj = 0; bj < 2; ++bj)
#pragma unroll
                    for (int n = 0; n < 2; ++n) acc[ai][bj][m][n] *= sc; }
    }
    __device__ __forceinline__ void operator()(const pg8::f32x4 (&acc)[2][2][4][2], const pg8::Unit& u, int wr, int wc, int fr, int fq) const {
#pragma unroll
        for (int ai = 0; ai < 2; ++ai)
#pragma unroll
            for (int m = 0; m < 4; ++m) {
                const size_t roff = (size_t)(u.pm * 256 + ai * 128 + wr * 64 + m * 16 + fr) * ldc;
#pragma unroll
                for (int bj = 0; bj < 2; ++bj)
#pragma unroll
                    for (int n = 0; n < 2; ++n) { const int col = u.pn * 256 + bj * 128 + wc * 32 + n * 16 + 4 * fq;
                        pg8::f32x4 rv;
                        if (r_bf16) { const uint2 rb = *(const uint2*)((const bf16*)R + roff + col); rv = (pg8::f32x4){bf_lo(rb.x), bf_hi(rb.x), bf_lo(rb.y), bf_hi(rb.y)}; }
                        else rv = *(const pg8::f32x4*)((const float*)R + roff + col);
                        const pg8::f32x4 o_ = acc[ai][bj][m][n] + rv;
                        *(uint2*)(C + roff + col) = make_uint2(pk2(o_[0], o_[1]), pk2(o_[2], o_[3])); }
            }
    }
};

#include <hip/hip_bf16.h>
#include <cmath>
template <bool REMAP> __device__ __forceinline__ void p0_transpose_item(const float* W, int K, int N, bf16* WT, LAS float* scr, int item, int lane, int nblk, const float* kscale = nullptr, int kscale_n = 0) {
    const int kb = item / nblk, nb = item % nblk, k0 = 64 * kb, n0 = 32 * nb;
    const int ncol = n0 + (lane & 31);
    float wl[32];
#pragma unroll
    for (int i = 0; i < 32; ++i) { const int kk = 2 * i + (lane >> 5); wl[i] = (ncol < N) ? W[(size_t)(k0 + kk) * N + ncol] : 0.f; }
#pragma unroll
    for (int i = 0; i < 32; ++i) { const int kk = 2 * i + (lane >> 5); float wv_ = wl[i];
        if (kscale && k0 + kk < kscale_n) wv_ *= kscale[k0 + kk];
        scr[kk * 33 + (lane & 31)] = wv_; }
    asm volatile("s_waitcnt lgkmcnt(0)" ::: "memory");
    const int ch = lane & 7;
#pragma unroll
    for (int j = 0; j < 4; ++j) { const int n = (lane >> 3) + 8 * j; const LAS float* sp = scr + (8 * ch) * 33 + n;
        uint4 o; o.x = pk2(sp[0 * 33], sp[1 * 33]); o.y = pk2(sp[2 * 33], sp[3 * 33]); o.z = pk2(sp[4 * 33], sp[5 * 33]); o.w = pk2(sp[6 * 33], sp[7 * 33]);
        int drow = n0 + n;
        if (REMAP) { if (drow >= 1536 && drow < 1544) drow += NF - 1536; else if (drow >= 1544 && drow < IN_COLS) drow -= 8; }
        *(uint4*)(WT + (size_t)drow * K + k0 + 8 * ch) = o; }
    asm volatile("s_waitcnt lgkmcnt(0)" ::: "memory");
}
constexpr int WI_IN = 16 * (NIN_PAD / 32), WI_OUT = 16 * (D / 32), WI_Q = 16 * (2048 / 32), WI_L = WI_IN + WI_OUT + WI_Q;
struct WeightJob { const float* w_in; const float* w_out; const float* w_query; const float* gmix; bf16* WT; int it0, it1; };
__device__ __forceinline__ void weight_item(const WeightJob& W, int it, LAS float* scr, int lane) {
    const int l = it / WI_L; int r = it % WI_L;
    bf16* base = W.WT + (size_t)l * WROWS_PER_LAYER * D;
    if (r < WI_IN) { p0_transpose_item<true>(W.w_in + (size_t)l * D * IN_COLS, D, IN_COLS, base, scr, r, lane, NIN_PAD / 32); return; } r -= WI_IN;
    if (r < WI_OUT) { p0_transpose_item<false>(W.w_out + (size_t)l * D * D, D, D, base + (size_t)NIN_PAD * D, scr, r, lane, D / 32, W.gmix + (size_t)l * D, 512); return; } r -= WI_OUT;
    p0_transpose_item<false>(W.w_query + (size_t)l * D * 2048, D, 2048, base + (size_t)(NIN_PAD + D) * D, scr, r, lane, 2048 / 32);
}
__device__ __forceinline__ LAS float* weight_scr(LAS unsigned char* lds, int wave) { return (LAS float*)(lds + wave * 16384 + 1024); }
__device__ __forceinline__ int weight_units(const WeightJob& W) { return (W.it1 - W.it0 + 31) / 32; }
__device__ __forceinline__ void weight_unit(const WeightJob& W, int wu, LAS unsigned char* lds, int wave, int lane) {
    LAS float* scr = weight_scr(lds, wave);
#pragma unroll 1
    for (int k = 0; k < 4; ++k) { const int it = W.it0 + 32 * wu + wave + 8 * k; if (it < W.it1) weight_item(W, it, scr, lane); }
}
struct QuantJob { const float* eu; const float* ev; unsigned char* EU; unsigned char* EV; float* ES; int l; };
constexpr int QUANT_UNITS = 2 * NEXP / 128;
__device__ __forceinline__ float wave_max63(float v) {
    v = fmaxf(v, __builtin_bit_cast(float, __builtin_amdgcn_update_dpp(0, __builtin_bit_cast(int, v), 0xB1, 0xF, 0xF, false)));
    v = fmaxf(v, __builtin_bit_cast(float, __builtin_amdgcn_update_dpp(0, __builtin_bit_cast(int, v), 0x4E, 0xF, 0xF, false)));
    v = fmaxf(v, __builtin_bit_cast(float, __builtin_amdgcn_update_dpp(0, __builtin_bit_cast(int, v), 0x141, 0xF, 0xF, false)));
    v = fmaxf(v, __builtin_bit_cast(float, __builtin_amdgcn_update_dpp(0, __builtin_bit_cast(int, v), 0x140, 0xF, 0xF, false)));
    v = fmaxf(v, __builtin_bit_cast(float, __builtin_amdgcn_update_dpp(0, __builtin_bit_cast(int, v), 0x142, 0xA, 0xF, false)));
    v = fmaxf(v, __builtin_bit_cast(float, __builtin_amdgcn_update_dpp(0, __builtin_bit_cast(int, v), 0x143, 0xC, 0xF, false)));
    return __builtin_bit_cast(float, __builtin_amdgcn_readlane(__builtin_bit_cast(int, v), 63));
}
__device__ __forceinline__ void quant_unit(const QuantJob& J, int qu, int wave, int lane) {
    const int tbl = qu / (NEXP / 128), e0 = (qu % (NEXP / 128)) * 128 + wave * 16;
    const float* srcb = (tbl ? J.ev : J.eu) + ((size_t)J.l * NEXP + e0) * D;
    unsigned char* dstb = (tbl ? J.EV : J.EU) + (size_t)J.l * NEXP * D + ((size_t)(lane >> 3) * NEXP + e0) * 128 + 16 * (lane & 7);
    float* esb = J.ES + (size_t)tbl * (DEPTH * NEXP) + (size_t)J.l * NEXP + e0;
    const float qmax = tbl ? 448.f : 127.f;
#pragma unroll 1
    for (int g = 0; g < 16; g += 4) {
        float4 x[4][4];
#pragma unroll
        for (int k = 0; k < 4; ++k)
#pragma unroll
            for (int j = 0; j < 4; ++j) x[k][j] = ((const float4*)(srcb + (size_t)(g + k) * D))[4 * lane + j];
#pragma unroll
        for (int k = 0; k < 4; ++k) {
            float am = 0.f;
#pragma unroll
            for (int j = 0; j < 4; ++j) am = fmaxf(am, fmaxf(fmaxf(fabsf(x[k][j].x), fabsf(x[k][j].y)), fmaxf(fabsf(x[k][j].z), fabsf(x[k][j].w))));
            am = wave_max63(am);
            const float inv = am > 0.f ? qmax / am : 0.f;
            unsigned pk[4];
#pragma unroll
            for (int j = 0; j < 4; ++j) {
                if (tbl) { int w = __builtin_amdgcn_cvt_pk_fp8_f32(x[k][j].x * inv, x[k][j].y * inv, 0, false); w = __builtin_amdgcn_cvt_pk_fp8_f32(x[k][j].z * inv, x[k][j].w * inv, w, true); pk[j] = (unsigned)w; }
                else pk[j] = pack4_i8(x[k][j].x, x[k][j].y, x[k][j].z, x[k][j].w, inv); }
            *(uint4*)(dstb + (size_t)(g + k) * 128) = make_uint4(pk[0], pk[1], pk[2], pk[3]);
            if (lane == 0) esb[g + k] = am / qmax;
        }
    }
}
namespace attn_body {
using bf16=__hip_bfloat16;
using bf16x8=__attribute__((ext_vector_type(8)))short;
using s16x4=__attribute__((ext_vector_type(4)))short;
using f32x16=__attribute__((ext_vector_type(16)))float;
using u32x4=__attribute__((ext_vector_type(4)))unsigned;
constexpr int BATCH=2,NHEAD=8,SEQ=8192,D=64,IP=3072,OP=1024;
constexpr float SKIP_L2=40.f;
constexpr int NW=8,QBLK=32,QB=QBLK*NW,KVBLK=64,NQB=SEQ/QB;
constexpr int ATTN_UNIT_ROWS=QB;
__device__ __forceinline__ int crow(int r,int hi){return (r&3)+8*(r>>2)+4*hi;}
#define SBAR() __builtin_amdgcn_sched_barrier(0)
__device__ __forceinline__ void cmask(f32x16&p0,f32x16&p1,int jb,int qrel,int hi){
  const float NEG=-INFINITY; int kb=64*jb+4*hi;
  #pragma unroll
  for(int r=0;r<16;++r){int kv=kb+(r&3)+8*(r>>2); if(kv>qrel)p0[r]=NEG; if(kv+32>qrel)p1[r]=NEG;}
}

constexpr int NSLOT=3, SLOTB=8192;
constexpr int LDS_K=0, LDS_V=NSLOT*SLOTB, LDS_WS=2*NSLOT*SLOTB, LDS_OST=LDS_WS+NW*64*4, LDS_G=LDS_OST+NW*4096, LDS_BYTES=LDS_G+SEQ*4;
constexpr float C2=0.125f*1.4426950408889634f;
__device__ __forceinline__ void glds16(const void*gsrc,unsigned lds_dst){unsigned keep;
  asm volatile("s_mov_b32 %0, m0\n\ts_mov_b32 m0, %2\n\ts_nop 0\n\tglobal_load_lds_dwordx4 %1, off\n\ts_mov_b32 m0, %0":"=&s"(keep):"v"(gsrc),"s"(lds_dst):"memory");}
__device__ __forceinline__ float max3f(float a,float b,float c){float r;asm("v_max3_f32 %0, %1, %2, %3":"=v"(r):"v"(a),"v"(b),"v"(c));return r;}
__device__ __forceinline__ float max2f(float a,float b){float r;asm("v_max_f32_e32 %0, %1, %2":"=v"(r):"v"(a),"v"(b));return r;}
__device__ __forceinline__ float fadd_s(float a,float b){float r;asm("v_add_f32_e32 %0, %1, %2":"=v"(r):"v"(a),"v"(b));return r;}
__device__ __forceinline__ float fsub_s(float a,float b){float r;asm("v_sub_f32_e32 %0, %1, %2":"=v"(r):"v"(a),"v"(b));return r;}
typedef float f32x2_t __attribute__((ext_vector_type(2))); typedef __bf16 bf16x2_t __attribute__((ext_vector_type(2)));
__device__ __forceinline__ unsigned cvtpk_s(float lo,float hi){f32x2_t v={lo,hi};bf16x2_t b=__builtin_convertvector(v,bf16x2_t);return __builtin_bit_cast(unsigned,b);}
#define WAIT_BAR(N) asm volatile("s_waitcnt vmcnt(" #N ") lgkmcnt(0)\n\ts_barrier":::"memory")

__device__ __forceinline__ void qkt(f32x16&p0,f32x16&p1,const char*Kslot,const bf16x8*qr,int r32,int hi){
  const char*kb=Kslot+hi*1024+r32*16;
  #pragma unroll
  for(int d0=0;d0<4;++d0){
    const bf16x8 b0=*reinterpret_cast<const bf16x8*>(kb+d0*2048);
    const bf16x8 b1=*reinterpret_cast<const bf16x8*>(kb+d0*2048+512);
    p0=__builtin_amdgcn_mfma_f32_32x32x16_bf16(b0,qr[d0],p0,0,0,0);p1=__builtin_amdgcn_mfma_f32_32x32x16_bf16(b1,qr[d0],p1,0,0,0);}
}
typedef __attribute__((address_space(3))) const char* lds_cptr;
typedef short v4i16_t __attribute__((ext_vector_type(4)));
__device__ __forceinline__ void kload8(bf16x8*kf,lds_cptr kp){
  kf[0]=*(const __attribute__((address_space(3))) bf16x8*)(kp);      kf[1]=*(const __attribute__((address_space(3))) bf16x8*)(kp+512);
  kf[2]=*(const __attribute__((address_space(3))) bf16x8*)(kp+2048); kf[3]=*(const __attribute__((address_space(3))) bf16x8*)(kp+2560);
  kf[4]=*(const __attribute__((address_space(3))) bf16x8*)(kp+4096); kf[5]=*(const __attribute__((address_space(3))) bf16x8*)(kp+4608);
  kf[6]=*(const __attribute__((address_space(3))) bf16x8*)(kp+6144); kf[7]=*(const __attribute__((address_space(3))) bf16x8*)(kp+6656);
}
__device__ __forceinline__ void kload2(bf16x8*kf,lds_cptr kp,int j){ kf[2*j]=*(const __attribute__((address_space(3))) bf16x8*)(kp+j*2048); kf[2*j+1]=*(const __attribute__((address_space(3))) bf16x8*)(kp+j*2048+512); }
__device__ __forceinline__ s16x4 vtr(lds_cptr p){ return __builtin_bit_cast(s16x4,__builtin_amdgcn_ds_read_tr16_b64_v4i16((__attribute__((address_space(3))) v4i16_t*)p)); }
__device__ __forceinline__ float rowmax(const f32x16&p0,const f32x16&p1){
  float a=max3f(p0[0],p0[1],p1[0]),b=max3f(p0[2],p0[3],p1[1]);a=max3f(a,p1[2],p1[3]);
  #pragma unroll
  for(int r=4;r<16;r+=4){a=max3f(a,p0[r],p0[r+1]);b=max3f(b,p0[r+2],p0[r+3]);a=max3f(a,p1[r],p1[r+1]);b=max3f(b,p1[r+2],p1[r+3]);}
  const float m=max2f(a,b);
  auto rr=__builtin_amdgcn_permlane32_swap(__float_as_uint(m),__float_as_uint(m),false,false);
  return max2f(__uint_as_float(rr[0]),__uint_as_float(rr[1]));
}
__device__ __forceinline__ void pv(f32x16*o,int vb,bf16x8 pa0,bf16x8 pa1,bf16x8 pa2,bf16x8 pa3){
  #pragma unroll
  for(int d0=0;d0<2;++d0){s16x4 lo[4],hi[4];
    #pragma unroll
    for(int ks=0;ks<4;++ks){
      asm volatile("ds_read_b64_tr_b16 %0,%1 offset:%c2":"=&v"(lo[ks]):"v"(vb),"i"(d0*4096+ks*1024):"memory");
      asm volatile("ds_read_b64_tr_b16 %0,%1 offset:%c2":"=&v"(hi[ks]):"v"(vb),"i"(d0*4096+ks*1024+512):"memory");}
    asm volatile("s_waitcnt lgkmcnt(0)":::"memory");SBAR();
    #define PK(k) (bf16x8){lo[k][0],lo[k][1],lo[k][2],lo[k][3],hi[k][0],hi[k][1],hi[k][2],hi[k][3]}
    o[d0]=__builtin_amdgcn_mfma_f32_32x32x16_bf16(pa0,PK(0),o[d0],0,0,0);
    o[d0]=__builtin_amdgcn_mfma_f32_32x32x16_bf16(pa1,PK(1),o[d0],0,0,0);
    o[d0]=__builtin_amdgcn_mfma_f32_32x32x16_bf16(pa2,PK(2),o[d0],0,0,0);
    o[d0]=__builtin_amdgcn_mfma_f32_32x32x16_bf16(pa3,PK(3),o[d0],0,0,0);
    #undef PK
  }
}

#ifndef ATTN_STORE16
#define ATTN_STORE16(p,v) (*(u32x4*)(p)=(v))
#endif
template<int THRL> __device__ __forceinline__ void attn_unit(int b,int h,int qb,const bf16*Q,const bf16*K,const bf16*V,bf16*O,const float*ZFt,float fbias,unsigned long long*RSQ,const unsigned long long*KN2,char*shm){
  const int tid_=tid_now();
  const int tid=tid_,lane=tid&63,r32=lane&31,hi=lane>>5; const int wid=__builtin_amdgcn_readfirstlane(tid>>6);
  const long rowbase=(long)b*SEQ; const int q0=qb*QB;
  const bf16*Qw=Q+(rowbase+q0+wid*QBLK)*IP+h*D;
  const bf16*Kh0=K+rowbase*IP+h*D,*Vh0=V+rowbase*IP+h*D;
  typedef float f32x4v __attribute__((ext_vector_type(4)));
  { const int n=q0+QB; __attribute__((address_space(3))) float*gl=(__attribute__((address_space(3))) float*)(shm+LDS_G);
    __attribute__((address_space(3))) float*wsum=(__attribute__((address_space(3))) float*)(shm+LDS_WS);
    float loc[16]; float run=0.f; const bool act=(16*tid<n);
    if(act){ const f32x4v*zs=(const f32x4v*)(ZFt+((long)b*NHEAD+h)*SEQ+16*tid);
      #pragma unroll
      for(int j4=0;j4<4;++j4){ const f32x4v z=zs[j4];
        #pragma unroll
        for(int j=0;j<4;++j){ const float x=z[j]+fbias; const float ls=fminf(x,0.f)-__logf(1.f+__expf(-fabsf(x))); run+=ls*1.4426950408889634f; loc[4*j4+j]=run; } } }
    float inc=run;
    #pragma unroll
    for(int o_=1;o_<64;o_<<=1){ const float t_=__shfl_up(inc,o_); if(lane>=o_)inc+=t_; }
    if(lane==63)wsum[wid]=inc;
    __syncthreads();
    float base=inc-run;
    for(int w_=0;w_<wid;++w_)base+=wsum[w_];
    if(act){
      #pragma unroll
      for(int j4=0;j4<4;++j4)*(__attribute__((address_space(3))) f32x4v*)(gl+16*tid+4*j4)=(f32x4v){loc[4*j4]+base,loc[4*j4+1]+base,loc[4*j4+2]+base,loc[4*j4+3]+base}; }
    __syncthreads(); }
  const float Gq=((const __attribute__((address_space(3))) float*)(shm+LDS_G))[q0+wid*QBLK+r32];
  bf16x8 qr[4];
  #pragma unroll
  for(int d0=0;d0<4;++d0)qr[d0]=*reinterpret_cast<const bf16x8*>(&Qw[(long)r32*IP+d0*16+hi*8]);
  int j0=0;
  { __attribute__((address_space(3))) float*red=(__attribute__((address_space(3))) float*)(shm+LDS_WS);
    const __attribute__((address_space(3))) float*glf=(const __attribute__((address_space(3))) float*)(shm+LDS_G);
    const int n=q0+QB; float km=0.f; const unsigned long long*kn=KN2+((long)b*NHEAD+h)*SEQ;
    { unsigned long long kv[16];
      #pragma unroll
      for(int k_=0;k_<16;++k_){const int i=tid+k_*NW*64; kv[k_]=(i<n)?kn[i]:0ull;}
      #pragma unroll
      for(int k_=0;k_<16;++k_)km=fmaxf(km,(float)kv[k_]); }
    float qs=0.f;
    #pragma unroll
    for(int d0=0;d0<4;++d0){
      #pragma unroll
      for(int j=0;j<8;++j){const float v=__uint_as_float((unsigned)(unsigned short)qr[d0][j]<<16);qs+=v*v;}}
    {auto rr=__builtin_amdgcn_permlane32_swap(__float_as_uint(qs),__float_as_uint(qs),false,false);qs=__uint_as_float(rr[0])+__uint_as_float(rr[1]);}
    float sd=0.f;
    { const bf16*Kd=Kh0+(long)(q0+wid*QBLK+r32)*IP+hi*8;
      #pragma unroll
      for(int d0=0;d0<4;++d0){ const bf16x8 kd=*reinterpret_cast<const bf16x8*>(&Kd[d0*16]);
        #pragma unroll
        for(int j=0;j<8;++j)sd+=__uint_as_float((unsigned)(unsigned short)qr[d0][j]<<16)*__uint_as_float((unsigned)(unsigned short)kd[j]<<16); } }
    {auto rr=__builtin_amdgcn_permlane32_swap(__float_as_uint(sd),__float_as_uint(sd),false,false);sd=__uint_as_float(rr[0])+__uint_as_float(rr[1]);}
    #pragma unroll
    for(int o_=1;o_<64;o_<<=1){km=fmaxf(km,__shfl_xor(km,o_));qs=fmaxf(qs,__shfl_xor(qs,o_));sd=fminf(sd,__shfl_xor(sd,o_));}
    if(lane==0){red[wid]=km;red[8+wid]=qs;red[32+wid]=sd;}
    __syncthreads();
    if(tid==0){ float k2=0.f,q2=0.f,sm=0.f;
      for(int w_=0;w_<NW;++w_){k2=fmaxf(k2,red[w_]);q2=fmaxf(q2,red[8+w_]);sm=fminf(sm,red[32+w_]);}
      const float S2=sqrtf(k2*(1.f/1048576.f)*q2)*1.02f, lowm=fmaxf(sm*1.02f-0.05f,-S2), thr=-(SKIP_L2+S2-lowm), g0=glf[q0];
      int lo=0,hiT=n/KVBLK-4;
      while(lo<hiT){const int mid=(lo+hiT)>>1; if(g0-glf[64*mid+63]<thr)lo=mid+1; else hiT=mid;}
      ((__attribute__((address_space(3))) int*)red)[16]=lo&~1; }
    __syncthreads();
    j0=__builtin_amdgcn_readfirstlane(((const __attribute__((address_space(3))) int*)red)[16]);
    __syncthreads(); }
  const bf16*Kh=Kh0+(long)j0*KVBLK*IP,*Vh=Vh0+(long)j0*KVBLK*IP;
  typedef __attribute__((address_space(3))) const f32x4v* lds_f4p;
  const lds_f4p gl0=(lds_f4p)(shm+LDS_G)+hi+16*j0;
  const unsigned lds0=(unsigned)(uintptr_t)shm;
  float*wsf=(float*)(shm+LDS_WS)+wid*64;
  const bf16*ksrc=Kh+(long)lane*IP+wid*8;
  const bf16*vsrc=Vh+(long)(16*(wid&3)+(lane>>2))*IP+(wid>>2)*32+(lane&3)*8;
  const unsigned kdst=lds0+LDS_K+wid*1024, vdst=lds0+LDS_V+wid*1024;
  #define DMA_K(t,slot) glds16(ksrc+(long)(t)*KVBLK*IP,(unsigned)__builtin_amdgcn_readfirstlane(kdst+(slot)))
  #define DMA_V(t,slot) glds16(vsrc+(long)(t)*KVBLK*IP,(unsigned)__builtin_amdgcn_readfirstlane(vdst+(slot)))
  const int vb0=(int)(lds0+LDS_V)+((lane>>4)&1)*32+(lane&3)*8+(4*hi+((lane&15)>>2))*64;
  const char*Kbase=shm+LDS_K; bf16x8 kf[8];
  const lds_cptr shm3=(lds_cptr)shm; const lds_cptr kp0=shm3+LDS_K+hi*1024+r32*16; const lds_cptr vp0=shm3+LDS_V+((lane>>4)&1)*32+(lane&3)*8+(4*hi+((lane&15)>>2))*64;
  const int NT=(q0+QB)/KVBLK-j0;
  DMA_K(0,0);DMA_V(0,0);DMA_K(1,SLOTB);
  float mhat=0.f,l_reg=0.f,gqm=Gq;f32x16 o[2];o[0]=f32x16{};o[1]=f32x16{};
  #define CINIT(C0,C1,t) do{ const lds_f4p gp_=gl0+16*(t); \
    _Pragma("unroll") for(int a_=0;a_<4;++a_){ const f32x4v g0_=gp_[2*a_],g1_=gp_[8+2*a_]; \
      C0[4*a_]=gqm-g0_.x;C0[4*a_+1]=gqm-g0_.y;C0[4*a_+2]=gqm-g0_.z;C0[4*a_+3]=gqm-g0_.w; \
      C1[4*a_]=gqm-g1_.x;C1[4*a_+1]=gqm-g1_.y;C1[4*a_+2]=gqm-g1_.z;C1[4*a_+3]=gqm-g1_.w; SBAR(); } }while(0)
  const int qrel=wid*QBLK+r32;
  #define CMASK(P0,P1,t) do{int jb_=(t)-(NT-4); if(jb_>=0)cmask(P0,P1,jb_,qrel,hi);}while(0)
  bool resc=false;
  #define START(P0,P1) do{ const float rm=rowmax(P0,P1); resc=false; \
    { const float dl=rm; mhat=fadd_s(mhat,dl); \
      _Pragma("unroll") for(int r=0;r<16;++r){P0[r]=fsub_s(P0[r],dl);P1[r]=fsub_s(P1[r],dl);} \
      gqm=fsub_s(gqm,dl); } \
    _Pragma("unroll") for(int r=0;r<16;++r)P0[r]=__builtin_amdgcn_exp2f(P0[r]); }while(0)
  #define RESC() do{ if(resc){ asm volatile("s_waitcnt lgkmcnt(0)":::"memory"); \
      _Pragma("unroll") for(int d_=0;d_<2;++d_) _Pragma("unroll") for(int r=0;r<16;++r)o[d_][r]*=wsf[crow(r,hi)]; } }while(0)
  f32x16 pA0,pA1,pB0,pB1;
  int sl_prev=0,sl_cur=0,sl_next=SLOTB;
  #define ROT() do{sl_prev=sl_cur;sl_cur=sl_next;sl_next=(sl_next==(NSLOT-1)*SLOTB)?0:sl_next+SLOTB;}while(0)
  DMA_K(2,2*SLOTB);
  WAIT_BAR(3);
  CINIT(pA0,pA1,0); qkt(pA0,pA1,Kbase,qr,r32,hi);asm volatile("s_nop 15\n\ts_nop 7":"+v"(pA0),"+v"(pA1));CMASK(pA0,pA1,0);
  START(pA0,pA1);
  _Pragma("unroll") for(int r=0;r<16;++r)pA1[r]=__builtin_amdgcn_exp2f(pA1[r]);
  WAIT_BAR(0);
  DMA_K(3,0);DMA_V(1,SLOTB);
  ROT();
  kload8(kf,kp0+sl_cur);
  WAIT_BAR(2);
  s16x4 vlo[8],vhi[8]; u32x4 pw0,pw1,pw2,pw3;
  #define PKW(P,B) cvtpk_s(P[B],P[B+1])
  #define PAF(k) __builtin_bit_cast(bf16x8,pw##k)
  #define VFR(i) (bf16x8){vlo[i][0],vlo[i][1],vlo[i][2],vlo[i][3],vhi[i][0],vhi[i][1],vhi[i][2],vhi[i][3]}
  #define PIN(x) asm volatile("":"+v"(x))
  #define MX3(a,b,c) __builtin_fmaxf(__builtin_fmaxf((a),(b)),(c))
  #define GAPA(MF,A0,A1,A2,A3,W0,W1,PW) do{ MF; sacc+=A0; sacc+=A1; sacc+=A2; sacc+=A3; PIN(sacc); W0; W1; PIN(PW); SBAR(); }while(0)
  #define EX(v) __builtin_amdgcn_exp2f(v)
  #define GAPB(MF,X,B,GN,PX,A4,OFF) do{ f32x4v g_; if(GN){g_=gpn_[OFF];} MF; X[B]=EX(X[B]); X[B+1]=EX(X[B+1]); X[B+2]=EX(X[B+2]); X[B+3]=EX(X[B+3]); PIN(X); \
      if(GN){PX[A4]=gqm-g_.x;PX[A4+1]=gqm-g_.y;PX[A4+2]=gqm-g_.z;PX[A4+3]=gqm-g_.w;PIN(PX);} SBAR(); }while(0)
  #define VRD(i) do{ vlo[i]=vtr(vp_+(((i)>>2)*4096+((i)&3)*1024)); vhi[i]=vtr(vp_+(((i)>>2)*4096+((i)&3)*1024+512)); }while(0)
  #define KRD(G,j) do{ if(G){ kload2(kf,kp0+sl_next,j); SBAR(); } }while(0)
  #define STEP(C0,C1,P0,P1,t,GK,GV,GL,GN) do{ SBAR(); const lds_f4p gpn_=gl0+16*((t)+1); \
    const lds_cptr vp_=vp0+sl_prev; \
    VRD(0); SBAR(); float sacc=(P0[0]+P0[1]); \
    GAPA(C0=__builtin_amdgcn_mfma_f32_32x32x16_bf16(kf[0],qr[0],C0,0,0,0), P0[2],P0[3],P0[4],P0[5],     pw0[0]=PKW(P0,0), pw0[1]=PKW(P0,2), pw0); \
    VRD(4); SBAR(); GAPA(C1=__builtin_amdgcn_mfma_f32_32x32x16_bf16(kf[1],qr[0],C1,0,0,0), P0[6],P0[7],P0[8],P0[9],     pw0[2]=PKW(P0,4), pw0[3]=PKW(P0,6), pw0); \
    VRD(1); SBAR(); GAPA(C0=__builtin_amdgcn_mfma_f32_32x32x16_bf16(kf[2],qr[1],C0,0,0,0),   P0[10],P0[11],P0[12],P0[13], pw1[0]=PKW(P0,8), pw1[1]=PKW(P0,10), pw1); \
    VRD(5); SBAR(); GAPA(C1=__builtin_amdgcn_mfma_f32_32x32x16_bf16(kf[3],qr[1],C1,0,0,0),   P0[14],P0[15],P1[0],P1[1],   pw1[2]=PKW(P0,12),pw1[3]=PKW(P0,14), pw1); \
    VRD(2); SBAR(); GAPA(C0=__builtin_amdgcn_mfma_f32_32x32x16_bf16(kf[4],qr[2],C0,0,0,0),   P1[2],P1[3],P1[4],P1[5],     pw2[0]=PKW(P1,0), pw2[1]=PKW(P1,2), pw2); \
    VRD(6); SBAR(); GAPA(C1=__builtin_amdgcn_mfma_f32_32x32x16_bf16(kf[5],qr[2],C1,0,0,0),   P1[6],P1[7],P1[8],P1[9],     pw2[2]=PKW(P1,4), pw2[3]=PKW(P1,6), pw2); \
    VRD(3); SBAR(); GAPA(C0=__builtin_amdgcn_mfma_f32_32x32x16_bf16(kf[6],qr[3],C0,0,0,0),   P1[10],P1[11],P1[12],P1[13], pw3[0]=PKW(P1,8), pw3[1]=PKW(P1,10), pw3); \
    VRD(7); SBAR(); GAPA(C1=__builtin_amdgcn_mfma_f32_32x32x16_bf16(kf[7],qr[3],C1,0,0,0),   P1[14],P1[15],0.f,0.f,       pw3[2]=PKW(P1,12),pw3[3]=PKW(P1,14), pw3); \
    l_reg+=sacc; \
    if(GK){DMA_K((t)+3,sl_cur);} if(GV){DMA_V((t)+1,sl_next);} \
    CMASK(C0,C1,t); \
    { float a=MX3(C0[0],C0[1],C1[0]),b=MX3(C0[2],C0[3],C1[1]); a=MX3(a,C1[2],C1[3]); \
      _Pragma("unroll") for(int r=4;r<16;r+=4){a=MX3(a,C0[r],C0[r+1]);b=MX3(b,C0[r+2],C0[r+3]);a=MX3(a,C1[r],C1[r+1]);b=MX3(b,C1[r+2],C1[r+3]);} \
      float rm=__builtin_fmaxf(a,b); { auto rr=__builtin_amdgcn_permlane32_swap(__float_as_uint(rm),__float_as_uint(rm),false,false); rm=__builtin_fmaxf(__uint_as_float(rr[0]),__uint_as_float(rr[1])); } \
      resc=false; \
      if(__builtin_expect(__any(rm>(float)THRL),0)){ const float dl=__builtin_fmaxf(rm,0.f); mhat+=dl; \
        _Pragma("unroll") for(int r=0;r<16;++r){C0[r]-=dl;C1[r]-=dl;} \
        gqm-=dl; \
        const float f=__builtin_amdgcn_exp2f(-dl); l_reg*=f; if(hi==0)wsf[r32]=f; resc=true; } } \
    SBAR(); \
    GAPB(o[0]=__builtin_amdgcn_mfma_f32_32x32x16_bf16(PAF(0),VFR(0),o[0],0,0,0), C0,0,  GN,P0,0,0); \
    GAPB(o[1]=__builtin_amdgcn_mfma_f32_32x32x16_bf16(PAF(0),VFR(4),o[1],0,0,0), C0,4,  GN,P0,4,2); \
    KRD(GL,0); GAPB(o[0]=__builtin_amdgcn_mfma_f32_32x32x16_bf16(PAF(1),VFR(1),o[0],0,0,0), C0,8,  GN,P0,8,4); \
    KRD(GL,1); GAPB(o[1]=__builtin_amdgcn_mfma_f32_32x32x16_bf16(PAF(1),VFR(5),o[1],0,0,0), C0,12, GN,P0,12,6); \
    KRD(GL,2); GAPB(o[0]=__builtin_amdgcn_mfma_f32_32x32x16_bf16(PAF(2),VFR(2),o[0],0,0,0), C1,0,  GN,P1,0,8); \
    KRD(GL,3); GAPB(o[1]=__builtin_amdgcn_mfma_f32_32x32x16_bf16(PAF(2),VFR(6),o[1],0,0,0), C1,4,  GN,P1,4,10); \
    GAPB(o[0]=__builtin_amdgcn_mfma_f32_32x32x16_bf16(PAF(3),VFR(3),o[0],0,0,0), C1,8,  GN,P1,8,12); \
    GAPB(o[1]=__builtin_amdgcn_mfma_f32_32x32x16_bf16(PAF(3),VFR(7),o[1],0,0,0), C1,12, GN,P1,12,14); \
    }while(0)
  int t=1;
  CINIT(pB0,pB1,1);
  #undef CMASK
  #define CMASK(P0,P1,t) do{}while(0)
  for(;t+5<NT;t+=2){
    STEP(pB0,pB1,pA0,pA1,t,true,true,true,true);     WAIT_BAR(2); RESC(); ROT();
    STEP(pA0,pA1,pB0,pB1,t+1,true,true,true,true);   WAIT_BAR(2); RESC(); ROT();
  }
  #undef CMASK
  #define CMASK(P0,P1,t) do{int jb_=(t)-(NT-4); if(jb_>=0)cmask(P0,P1,jb_,qrel,hi);}while(0)
  #define ENDW(tt) do{ if((tt)+3<NT){WAIT_BAR(2);} else if((tt)+2<NT){WAIT_BAR(1);} else {WAIT_BAR(0);} }while(0)
  for(;t+1<NT;t+=2){
    STEP(pB0,pB1,pA0,pA1,t,(t+3<NT),(t+1<NT),(t+1<NT),true);       ENDW(t);   RESC(); ROT();
    STEP(pA0,pA1,pB0,pB1,t+1,(t+4<NT),(t+2<NT),(t+2<NT),true);     ENDW(t+1); RESC(); ROT();
  }
  STEP(pB0,pB1,pA0,pA1,NT-1,false,false,false,false); RESC();
  { float sacc=pB0[0]+pB0[1]; _Pragma("unroll") for(int r=2;r<16;++r)sacc+=pB0[r]; _Pragma("unroll") for(int r=0;r<16;++r)sacc+=pB1[r]; l_reg+=sacc;
    pw0=(u32x4){PKW(pB0,0),PKW(pB0,2),PKW(pB0,4),PKW(pB0,6)};pw1=(u32x4){PKW(pB0,8),PKW(pB0,10),PKW(pB0,12),PKW(pB0,14)};pw2=(u32x4){PKW(pB1,0),PKW(pB1,2),PKW(pB1,4),PKW(pB1,6)};pw3=(u32x4){PKW(pB1,8),PKW(pB1,10),PKW(pB1,12),PKW(pB1,14)};
    SBAR(); pv(o,vb0+sl_cur,PAF(0),PAF(1),PAF(2),PAF(3)); }
  #undef PKW
  #undef PAF
  #undef VFR
  #undef PIN
  #undef MX3
  #undef GAPA
  #undef GAPB
  #undef EX
  #undef VRD
  #undef KRD
  #undef STEP
  #undef ENDW
  {auto rr=__builtin_amdgcn_permlane32_swap(__float_as_uint(l_reg),__float_as_uint(l_reg),false,false);l_reg=__uint_as_float(rr[0])+__uint_as_float(rr[1]);}
  if(hi==0)wsf[32+r32]=l_reg;asm volatile("s_waitcnt lgkmcnt(0)":::"memory");
  float rli[16];
  #pragma unroll
  for(int r=0;r<16;++r)rli[r]=__builtin_amdgcn_rcpf(wsf[32+crow(r,hi)]);
  bf16*Ow=O+(rowbase+q0+wid*QBLK)*OP+h*D;
  { bf16*stg=(bf16*)(shm+LDS_OST)+wid*2048;
    #pragma unroll
    for(int r=0;r<16;++r){const int orow=crow(r,hi);
      #pragma unroll
      for(int d0=0;d0<2;++d0)stg[orow*64+d0*32+r32]=__float2bfloat16(o[d0][r]*rli[r]);}
    asm volatile("s_waitcnt lgkmcnt(0)":::"memory");
    int le=lane; asm volatile("":"+v"(le));
    #pragma unroll
    for(int i=0;i<4;++i){const int row=i*8+(le>>3),ch=le&7; const u32x4 v=*(const u32x4*)(stg+row*64+ch*8); ATTN_STORE16(Ow+(long)row*OP+ch*8,v);
      float sq=0.f;
      #pragma unroll
      for(int j=0;j<4;++j){const float lo_=__uint_as_float(v[j]<<16),hi_=__uint_as_float(v[j]&0xffff0000u);sq+=lo_*lo_+hi_*hi_;}
      sq+=__uint_as_float((unsigned)__builtin_amdgcn_update_dpp(0,(int)__float_as_uint(sq),0xB1,0xF,0xF,false));
      sq+=__uint_as_float((unsigned)__builtin_amdgcn_update_dpp(0,(int)__float_as_uint(sq),0x4E,0xF,0xF,false));
      sq+=__uint_as_float((unsigned)__builtin_amdgcn_update_dpp(0,(int)__float_as_uint(sq),0x141,0xF,0xF,false));
      if(ch==0)atomicAdd(RSQ+rowbase+q0+wid*QBLK+row,(unsigned long long)(sq*16777216.f));} }
  asm volatile("s_waitcnt lgkmcnt(0)\n\ts_barrier":::"memory");
  #undef DMA_K
  #undef DMA_V
  #undef CMASK
  #undef START
  #undef RESC
  #undef ROT
  #undef CINIT
}
constexpr int ATTN_LDS_BYTES=LDS_BYTES;
struct AttnTensors { const bf16* Q; const bf16* K; const bf16* V; bf16* O; const float* ZFt; const float* bf; unsigned long long* RSQ; const unsigned long long* KN2; };
struct AttnUnit { int bh; int qb; };
struct StaticOrder {
  int vcu;
  __device__ __forceinline__ explicit StaticOrder(int grid,int block):vcu((block%8)*(grid/8)+block/8){}
  __device__ __forceinline__ bool next(int i,AttnUnit&u)const{ if(i>=2)return false; const int s=vcu&15; u.bh=vcu>>4; u.qb=(i==0)?31-s:s; return true; }
  __device__ __forceinline__ void a_ready(const AttnUnit&)const{}
  __device__ __forceinline__ void done(const AttnUnit&)const{}
};
template<int THRL=60> __device__ __forceinline__ void attn_phase_dyn(char*lds,const AttnTensors&T,unsigned*qctr,int block,const ::QuantJob&J,const ::WeightJob&WJ){
  const int nside=::QUANT_UNITS+::weight_units(WJ);
  __attribute__((address_space(3))) int*uw=(__attribute__((address_space(3))) int*)(lds+LDS_WS)+24;
  for(;;){
    const int tn=::tid_now();
    if(tn==0)*uw=(int)atomicAdd(qctr,1u);
    __syncthreads();
    const int ix=__builtin_amdgcn_readfirstlane(*(volatile __attribute__((address_space(3))) int*)uw);
    __syncthreads();
    if(ix>=BATCH*NHEAD*NQB+((nside+1)&~1))break;
    const int jx=ix-256,nsd=(nside+1)&~1,nb3=3*(nsd>>1);
    int u=ix;
    if(jx>=0){
      if(jx<nb3){
        if(jx%3!=2){ const int si=(jx/3)*2+jx%3,wv=__builtin_amdgcn_readfirstlane(tn>>6);
          if(si<nside){ if(si<nside-::QUANT_UNITS) ::weight_unit(WJ,si,(__attribute__((address_space(3))) unsigned char*)lds,wv,tn&63); else ::quant_unit(J,si-(nside-::QUANT_UNITS),wv,tn&63); }
          continue; }
        u=256+jx/3; }
      else u=256+(nsd>>1)+(jx-nb3); }
    const int qb=NQB-1-(u>>4),bh=u&15;
    attn_unit<THRL>(bh>>3,bh&7,qb,T.Q,T.K,T.V,T.O,T.ZFt,T.bf[bh&7],T.RSQ,T.KN2,lds);
  }
}
template<class Sched,int THRL=60> __device__ __forceinline__ void attn_phase(char*lds,const AttnTensors&T,const Sched&S){
  AttnUnit u;
  for(int i=0;S.next(i,u);++i){ S.a_ready(u); attn_unit<THRL>(u.bh/NHEAD,u.bh%NHEAD,u.qb,T.Q,T.K,T.V,T.O,T.ZFt,T.bf[u.bh%NHEAD],T.RSQ,T.KN2,lds); S.done(u); }
}
#undef SBAR
#undef WAIT_BAR
}

__device__ __forceinline__ float wave_sum(float v) {
    v += __uint_as_float((unsigned)__builtin_amdgcn_update_dpp(0, (int)__float_as_uint(v), 0xB1, 0xF, 0xF, false));
    v += __uint_as_float((unsigned)__builtin_amdgcn_update_dpp(0, (int)__float_as_uint(v), 0x4E, 0xF, 0xF, false));
    v += __uint_as_float((unsigned)__builtin_amdgcn_update_dpp(0, (int)__float_as_uint(v), 0x141, 0xF, 0xF, false));
    v += __uint_as_float((unsigned)__builtin_amdgcn_update_dpp(0, (int)__float_as_uint(v), 0x140, 0xF, 0xF, false));
    v += __uint_as_float((unsigned)__builtin_amdgcn_update_dpp(0, (int)__float_as_uint(v), 0x142, 0xA, 0xF, false));
    v += __uint_as_float((unsigned)__builtin_amdgcn_update_dpp(0, (int)__float_as_uint(v), 0x143, 0xC, 0xF, false));
    return __uint_as_float((unsigned)__builtin_amdgcn_readlane((int)__float_as_uint(v), 63));
}

struct Ctx { int tid, lane, wave, bid, nblk; float* lds; };

template <bool Q8, bool XBF> __device__ __forceinline__ void ph_rmsnorm_bf16(const Ctx& c, const void* X, const float* g, bf16* Y, unsigned char* Y8 = nullptr, float* SH = nullptr, unsigned long long* ZERO = nullptr, unsigned long long* ZKN = nullptr) {
    const int gw = c.bid * NWAVES + c.wave, NGW = c.nblk * NWAVES;
    for (int m0 = gw; m0 < T; m0 += 2 * NGW) {
        float4 v[2][4];
#pragma unroll
        for (int u = 0; u < 2; ++u) { const int m = (m0 + u * NGW < T) ? m0 + u * NGW : m0;
#pragma unroll
            for (int j = 0; j < 4; ++j) {
                if (XBF) { const uint2 rb = ((const uint2*)((const bf16*)X + (size_t)m * D) + c.lane)[64 * j]; v[u][j] = make_float4(bf_lo(rb.x), bf_hi(rb.x), bf_lo(rb.y), bf_hi(rb.y)); }
                else v[u][j] = ((const float4*)((const float*)X + (size_t)m * D) + c.lane)[64 * j]; } }
#pragma unroll
        for (int u = 0; u < 2; ++u) { const int m = m0 + u * NGW; if (m >= T) break;
            float s = 0.f;
#pragma unroll
            for (int j = 0; j < 4; ++j) s += v[u][j].x * v[u][j].x + v[u][j].y * v[u][j].y + v[u][j].z * v[u][j].z + v[u][j].w * v[u][j].w;
            const float r = rsqrtf(wave_sum(s) * (1.f / D) + EPS);
            if (ZERO && c.lane == 0) ZERO[m] = 0ull;
            if (ZKN && c.lane < NH) ZKN[(size_t)((m >> 13) * NH + c.lane) * S + (m & (S - 1))] = 0ull;
            uint2* yr = (uint2*)(Y + (size_t)m * D) + c.lane;
#pragma unroll
            for (int j = 0; j < 4; ++j) { const float4 gg = ((const float4*)g)[c.lane + 64 * j];
                v[u][j] = make_float4(v[u][j].x * r * gg.x, v[u][j].y * r * gg.y, v[u][j].z * r * gg.z, v[u][j].w * r * gg.w);
                yr[64 * j] = make_uint2(pk2(v[u][j].x, v[u][j].y), pk2(v[u][j].z, v[u][j].w)); }
            if (Q8) {
                float am = 0.f;
#pragma unroll
                for (int j = 0; j < 4; ++j) am = fmaxf(am, fmaxf(fmaxf(fabsf(v[u][j].x), fabsf(v[u][j].y)), fmaxf(fabsf(v[u][j].z), fabsf(v[u][j].w))));
                am = wave_max63(am);
                const float inv = am > 0.f ? 127.f / am : 0.f;
                unsigned pk[4];
#pragma unroll
                for (int j = 0; j < 4; ++j) pk[j] = pack4_i8(v[u][j].x, v[u][j].y, v[u][j].z, v[u][j].w, inv);
#pragma unroll
                for (int j = 0; j < 4; ++j) *(unsigned*)(Y8 + (size_t)m * D + 4 * c.lane + 256 * j) = pk[j];
                if (c.lane == 0) SH[m] = am * (1.f / 127.f);
            }
        }
    }
}
__device__ __forceinline__ void ph_rmsnorm(const Ctx& c, const bf16* X, const float* g, float* Y) {
    const int gw = c.bid * NWAVES + c.wave, NGW = c.nblk * NWAVES;
    for (int m = gw; m < T; m += NGW) {
        const uint2* xr = (const uint2*)(X + (size_t)m * D) + c.lane;
        float4 v[4]; float s = 0.f;
#pragma unroll
        for (int j = 0; j < 4; ++j) { const uint2 rb = xr[64 * j]; v[j] = make_float4(bf_lo(rb.x), bf_hi(rb.x), bf_lo(rb.y), bf_hi(rb.y)); s += v[j].x * v[j].x + v[j].y * v[j].y + v[j].z * v[j].z + v[j].w * v[j].w; }
        const float r = rsqrtf(wave_sum(s) * (1.f / D) + EPS);
        float4* yr = (float4*)(Y + (size_t)m * D) + c.lane;
#pragma unroll
        for (int j = 0; j < 4; ++j) { const float4 gg = ((const float4*)g)[c.lane + 64 * j];
            yr[64 * j] = make_float4(v[j].x * r * gg.x, v[j].y * r * gg.y, v[j].z * r * gg.z, v[j].w * r * gg.w); }
    }
}
__device__ __forceinline__ void ph_prologue(const Ctx& c, const WeightJob& W) {
    LAS float* scr = weight_scr((LAS unsigned char*)c.lds, c.wave);
    const int gw = c.bid * NWAVES + c.wave, NGW = c.nblk * NWAVES;
    for (int it = W.it0 + gw; it < W.it1; it += NGW) weight_item(W, it, scr, c.lane);
}

__device__ __forceinline__ float bfv(const bf16* p) { return __builtin_bit_cast(float, (unsigned)(*p) << 16); }
__device__ __forceinline__ float gelu_fast(float x) {
    const float u = 0.7978845608028654f * (x + 0.044715f * x * x * x);
    const float e = __expf(2.f * u);
    return 0.5f * x * (2.f - 2.f * __builtin_amdgcn_rcpf(e + 1.f));
}
__device__ __forceinline__ float dpp_row_sum16(float v) {
    v += __builtin_bit_cast(float, __builtin_amdgcn_update_dpp(0, __builtin_bit_cast(int, v), 0xB1, 0xF, 0xF, false));
    v += __builtin_bit_cast(float, __builtin_amdgcn_update_dpp(0, __builtin_bit_cast(int, v), 0x4E, 0xF, 0xF, false));
    v += __builtin_bit_cast(float, __builtin_amdgcn_update_dpp(0, __builtin_bit_cast(int, v), 0x141, 0xF, 0xF, false));
    v += __builtin_bit_cast(float, __builtin_amdgcn_update_dpp(0, __builtin_bit_cast(int, v), 0x140, 0xF, 0xF, false));
    return v;
}
constexpr int VNT_PITCH = 136;
__device__ __forceinline__ void mixlocal_unit(const Ctx& c, int u, const bf16* ZB, const float* wsp, const float* bsp, const float* sgu, const float* convw, const float* gmix, bf16* MIXN) {
    const int chk = u >> 1, hf = u & 1, trow0 = chk * CHUNK, ns = 64 * (hf + 1);
    LAS unsigned short* VNt = (LAS unsigned short*)c.lds;
    LAS float* RS = (LAS float*)((LAS unsigned char*)c.lds + 4 * 64 * VNT_PITCH * 2);
    uint4 raw8[8];
#pragma unroll
    for (int k = 0; k < 8; ++k) { const int it = c.tid + k * NTHR; if (it < ns * 32) { const int sI = ((it >> 8) << 3) + ((it >> 3) & 7), g = (it >> 6) & 3, oct = it & 7;
        raw8[k] = *(const uint4*)(ZB + (size_t)(trow0 + sI) * ZC + NGV + g * 64 + oct * 8); } }
    float4 wA[4][2][2]; unsigned short guv[2][4][4];
    { const int g = c.wave >> 1, rs = c.wave & 1, m = c.lane & 15, kq = c.lane >> 4; const int tl0 = 64 * hf + 32 * rs, nks = (tl0 + 32) / 32;
#pragma unroll
      for (int mt = 0; mt < 2; ++mt)
#pragma unroll
        for (int r = 0; r < 4; ++r) { const bf16* gur = ZB + (size_t)(trow0 + tl0 + 16 * mt + 4 * kq + r) * ZC + NGU + g * 64 + m;
#pragma unroll
            for (int nt = 0; nt < 4; ++nt) guv[mt][r][nt] = *(const unsigned short*)(gur + 16 * nt); }
#pragma unroll
      for (int ks = 0; ks < 4; ++ks) if (ks < nks) {
#pragma unroll
        for (int mt = 0; mt < 2; ++mt) { const float* wr = wsp + ((size_t)g * CHUNK + tl0 + 16 * mt + m) * CHUNK + 32 * ks + 8 * kq;
            wA[ks][mt][0] = *(const float4*)wr; wA[ks][mt][1] = *(const float4*)(wr + 4); } } }
#pragma unroll
    for (int k = 0; k < 8; ++k) { const int it = c.tid + k * NTHR; if (it < ns * 32) {
        const int sI = ((it >> 8) << 3) + ((it >> 3) & 7), g = (it >> 6) & 3, oct = it & 7;
        const uint4 raw = raw8[k];
        float v[8] = {bf_lo(raw.x), bf_hi(raw.x), bf_lo(raw.y), bf_hi(raw.y), bf_lo(raw.z), bf_hi(raw.z), bf_lo(raw.w), bf_hi(raw.w)};
        float ss = 0.f;
#pragma unroll
        for (int j = 0; j < 8; ++j) { v[j] = gelu_fast(v[j]); ss += v[j] * v[j]; }
        ss += __uint_as_float((unsigned)__builtin_amdgcn_update_dpp(0, (int)__float_as_uint(ss), 0xB1, 0xF, 0xF, false));
        ss += __uint_as_float((unsigned)__builtin_amdgcn_update_dpp(0, (int)__float_as_uint(ss), 0x4E, 0xF, 0xF, false));
        ss += __uint_as_float((unsigned)__builtin_amdgcn_update_dpp(0, (int)__float_as_uint(ss), 0x141, 0xF, 0xF, false));
        const float r = rsqrtf(ss * (1.f / 64.f) + EPS);
#pragma unroll
        for (int j = 0; j < 8; ++j) VNt[(g * 64 + oct * 8 + j) * VNT_PITCH + ((((sI >> 3) ^ oct) << 3) | (sI & 7))] = (unsigned short)f2bf(v[j] * r * sgu[g * 64 + oct * 8 + j]);
    } }
    __syncthreads();
    uint2 cvc[10], cvi[10], cvb[8]; const int cv_tg = trow0 + 64 * hf + 8 * c.wave, cv_ch = 4 * c.lane, cv_pos0 = cv_tg & (S - 1);
    {
        const int g = c.wave >> 1, rs = c.wave & 1, m = c.lane & 15, kq = c.lane >> 4;
        const int tl0 = 64 * hf + 32 * rs, nks = (tl0 + 32) / 32;
        pg8::f32x4 acc[2][4];
#pragma unroll
        for (int mt = 0; mt < 2; ++mt)
#pragma unroll
            for (int nt = 0; nt < 4; ++nt) acc[mt][nt] = (pg8::f32x4){0.f, 0.f, 0.f, 0.f};
#pragma unroll
        for (int ks = 0; ks < 4; ++ks) if (ks < nks) {
            pg8::bf16x8 af[2], bfr[4];
            const int s0 = 32 * ks + 8 * kq;
#pragma unroll
            for (int mt = 0; mt < 2; ++mt) { const int tau = tl0 + 16 * mt + m;
                const float4 w0 = wA[ks][mt][0], w1 = wA[ks][mt][1];
                const float wv[8] = {w0.x, w0.y, w0.z, w0.w, w1.x, w1.y, w1.z, w1.w};
                unsigned pk[4];
#pragma unroll
                for (int j = 0; j < 4; ++j) pk[j] = pk2((s0 + 2 * j <= tau) ? wv[2 * j] : 0.f, (s0 + 2 * j + 1 <= tau) ? wv[2 * j + 1] : 0.f);
                af[mt] = __builtin_bit_cast(pg8::bf16x8, (pg8::u32x4){pk[0], pk[1], pk[2], pk[3]}); }
#pragma unroll
            for (int nt = 0; nt < 4; ++nt) bfr[nt] = *(const LAS pg8::bf16x8*)(VNt + (g * 64 + 16 * nt + m) * VNT_PITCH + ((((s0 >> 3) ^ (((16 * nt + m) >> 3) & 7))) << 3));
#pragma unroll
            for (int mt = 0; mt < 2; ++mt)
#pragma unroll
                for (int nt = 0; nt < 4; ++nt) acc[mt][nt] = __builtin_amdgcn_mfma_f32_16x16x32_bf16(af[mt], bfr[nt], acc[mt][nt], 0, 0, 0);
        }
#pragma unroll
        for (int i = 0; i < 10; ++i) { const int row = cv_tg - 2 + i; const bool ok = (i >= 2) || (cv_pos0 >= 2 - i);
            cvc[i] = ok ? *(const uint2*)(ZB + (size_t)row * ZC + NCC + cv_ch) : make_uint2(0u, 0u); cvi[i] = ok ? *(const uint2*)(ZB + (size_t)row * ZC + NCI + cv_ch) : make_uint2(0u, 0u); }
#pragma unroll
        for (int i = 0; i < 8; ++i) cvb[i] = *(const uint2*)(ZB + (size_t)(cv_tg + i) * ZC + NCB + cv_ch);
        float sq[2][4];
#pragma unroll
        for (int mt = 0; mt < 2; ++mt)
#pragma unroll
            for (int r = 0; r < 4; ++r) { const int tau = tl0 + 16 * mt + 4 * kq + r; const float bias = bsp[g * CHUNK + tau];
                float q = 0.f;
#pragma unroll
                for (int nt = 0; nt < 4; ++nt) { const float val = gelu_fast(__uint_as_float((unsigned)guv[mt][r][nt] << 16)) * (acc[mt][nt][r] + bias); acc[mt][nt][r] = val; q += val * val; }
                sq[mt][r] = dpp_row_sum16(q); }
        if (m == 0) {
#pragma unroll
            for (int mt = 0; mt < 2; ++mt)
#pragma unroll
                for (int r = 0; r < 4; ++r) RS[g * 64 + 32 * rs + 16 * mt + 4 * kq + r] = sq[mt][r];
        }
        __syncthreads();
#pragma unroll
        for (int mt = 0; mt < 2; ++mt)
#pragma unroll
            for (int r = 0; r < 4; ++r) { const int lr = 32 * rs + 16 * mt + 4 * kq + r, tau = 64 * hf + lr;
                const float rstd = rsqrtf((RS[lr] + RS[64 + lr] + RS[128 + lr] + RS[192 + lr]) * (1.f / 256.f) + EPS);
                bf16* orow = MIXN + (size_t)(trow0 + tau) * D + 512 + g * 64 + m;
#pragma unroll
                for (int nt = 0; nt < 4; ++nt) orow[16 * nt] = (bf16)f2bf(acc[mt][nt][r] * rstd * gmix[512 + g * 64 + 16 * nt + m]); }
    }
    {
        const int tl = 64 * hf + 8 * c.wave, tg = trow0 + tl, ch = 4 * c.lane;
        const float4 w0 = *(const float4*)(convw + ch), w1 = *(const float4*)(convw + 256 + ch), w2 = *(const float4*)(convw + 512 + ch);
        const float4 gm = *(const float4*)(gmix + 768 + ch);
        auto zrow = [&](int i) { const uint2 cc = cvc[i], ci = cvi[i];
            return make_float4(bf_lo(cc.x) * bf_lo(ci.x), bf_hi(cc.x) * bf_hi(ci.x), bf_lo(cc.y) * bf_lo(ci.y), bf_hi(cc.y) * bf_hi(ci.y)); };
        float4 zm2 = zrow(0), zm1 = zrow(1);
#pragma unroll
        for (int i = 0; i < 8; ++i) {
            const float4 z0 = zrow(i + 2);
            const uint2 cb = cvb[i];
            float4 o;
            o.x = bf_lo(cb.x) * (w0.x * zm2.x + w1.x * zm1.x + w2.x * z0.x); o.y = bf_hi(cb.x) * (w0.y * zm2.y + w1.y * zm1.y + w2.y * z0.y);
            o.z = bf_lo(cb.y) * (w0.z * zm2.z + w1.z * zm1.z + w2.z * z0.z); o.w = bf_hi(cb.y) * (w0.w * zm2.w + w1.w * zm1.w + w2.w * z0.w);
            const float r = rsqrtf(wave_sum(o.x * o.x + o.y * o.y + o.z * o.z + o.w * o.w) * (1.f / 256.f) + EPS);
            *(uint2*)(MIXN + (size_t)(tg + i) * D + 768 + ch) = make_uint2(pk2(o.x * r * gm.x, o.y * r * gm.y), pk2(o.z * r * gm.z, o.w * r * gm.w));
            zm2 = zm1; zm1 = z0;
        }
    }
    __syncthreads();
}
__device__ __forceinline__ void tk_insert(float (&v)[16], int (&ix)[16], float s, int k) {
    if (s > v[15]) {
        v[15] = s; ix[15] = k;
#pragma unroll
        for (int j = 15; j > 0; --j) {
            const bool sw = v[j] > v[j - 1];
            const float a = v[j], bq = v[j - 1]; const int ia = ix[j], ib = ix[j - 1];
            v[j - 1] = sw ? a : bq; v[j] = sw ? bq : a; ix[j - 1] = sw ? ia : ib; ix[j] = sw ? ib : ia;
        }
    }
}
__device__ __forceinline__ float vmaxf(float a, float b) { float r; asm("v_max_f32_e32 %0, %1, %2" : "=v"(r) : "v"(a), "v"(b)); return r; }
__device__ __forceinline__ float vminf(float a, float b) { float r; asm("v_min_f32_e32 %0, %1, %2" : "=v"(r) : "v"(a), "v"(b)); return r; }
__device__ __forceinline__ void bitonic_sort16_desc(float (&v)[16]) {
#pragma unroll
    for (int k = 2; k <= 16; k <<= 1)
#pragma unroll
        for (int j = k >> 1; j > 0; j >>= 1)
#pragma unroll
            for (int i = 0; i < 16; ++i) { const int l = i ^ j;
                if (l > i) { const float hi = vmaxf(v[i], v[l]), lo = vminf(v[i], v[l]); const bool desc = ((i & k) == 0) || (k == 16);
                    v[i] = desc ? hi : lo; v[l] = desc ? lo : hi; } }
}
__device__ __forceinline__ void merge_top16_desc(float (&a)[16], const float (&b)[16]) {
#pragma unroll
    for (int i = 0; i < 16; ++i) a[i] = vmaxf(a[i], b[15 - i]);
#pragma unroll
    for (int j = 8; j > 0; j >>= 1)
#pragma unroll
        for (int i = 0; i < 16; ++i) { const int l = i ^ j; if (l > i) { const float hi = vmaxf(a[i], a[l]), lo = vminf(a[i], a[l]); a[i] = hi; a[l] = lo; } }
}
constexpr int SKL_PITCH = 136;
template <bool LOCAL> __device__ __forceinline__ void ph_topk1_mfma(const Ctx& c, const bf16* Q, const float* sk, float* TV, int* TI, int lt0 = 0, int lt1 = 0) {
    typedef float f32x16 __attribute__((ext_vector_type(16)));
    LAS unsigned short* SKl = (LAS unsigned short*)c.lds;
    for (int i = c.tid; i < 2 * NKEYS * DHALF / 4; i += NTHR) { const float4 x = ((const float4*)sk)[i]; const int row = i >> 5, c4 = i & 31;
        typedef unsigned u32x2v __attribute__((ext_vector_type(2))); *(LAS u32x2v*)(SKl + row * SKL_PITCH + c4 * 4) = (u32x2v){pk2(x.x, x.y), pk2(x.z, x.w)}; }
    __syncthreads();
    const int r32 = c.lane & 31, hi = c.lane >> 5;
    const int gw = c.bid * NWAVES + c.wave, NGW = c.nblk * NWAVES;
    for (int b = LOCAL ? c.wave : gw; b < (LOCAL ? 32 : T * PH * 2 / 32); b += (LOCAL ? NWAVES : NGW)) {
        const int half = b & 1; int L = (b >> 1) * 32 + r32;
        if (LOCAL) { const int lt = (b >> 4) ? lt1 : lt0; L = ((lt >> 3) * 256 + ((b >> 1) & 7) * 32 + r32) * 8 + (lt & 7); }
        const bf16* qp = Q + (size_t)L * DKEY + half * DHALF + 8 * hi;
        pg8::bf16x8 qf[8];
#pragma unroll
        for (int ks = 0; ks < 8; ++ks) qf[ks] = *(const pg8::bf16x8*)(qp + 16 * ks);
        f32x16 acc[4];
#pragma unroll
        for (int kb = 0; kb < 4; ++kb) acc[kb] = f32x16{};
        int aoff = (half * NKEYS + r32) * SKL_PITCH + 8 * hi; asm volatile("" : "+v"(aoff));
        const LAS unsigned short* ap = SKl + aoff;
#pragma unroll
        for (int ks = 0; ks < 8; ++ks) {
#pragma unroll
            for (int kb = 0; kb < 4; ++kb) { const pg8::bf16x8 af = *(const LAS pg8::bf16x8*)(ap + kb * 32 * SKL_PITCH + 16 * ks);
                acc[kb] = __builtin_amdgcn_mfma_f32_32x32x16_bf16(af, qf[ks], acc[kb], 0, 0, 0); }
        }
        float v0[16], v1[16], v2[16], v3[16];
#pragma unroll
        for (int r = 0; r < 16; ++r) { const unsigned key = (unsigned)((r & 3) + 8 * (r >> 2) + 4 * hi);
            const float a0 = acc[0][r], a1 = acc[1][r], a2 = acc[2][r], a3 = acc[3][r];
            v0[r] = __uint_as_float((__float_as_uint(a0) & ~127u) | key);
            v1[r] = __uint_as_float((__float_as_uint(a1) & ~127u) | (key + 32u));
            v2[r] = __uint_as_float((__float_as_uint(a2) & ~127u) | (key + 64u));
            v3[r] = __uint_as_float((__float_as_uint(a3) & ~127u) | (key + 96u)); }
        bitonic_sort16_desc(v0); bitonic_sort16_desc(v1); bitonic_sort16_desc(v2); bitonic_sort16_desc(v3);
        merge_top16_desc(v0, v1); merge_top16_desc(v2, v3); merge_top16_desc(v0, v2);
#pragma unroll
        for (int r = 0; r < 16; ++r) { const unsigned x = __builtin_bit_cast(unsigned, v0[r]); auto rr = __builtin_amdgcn_permlane32_swap(x, x, false, false);
            v1[r] = __builtin_bit_cast(float, hi ? rr[0] : rr[1]); }
        merge_top16_desc(v0, v1);
        if (hi == 0) { const size_t o = ((size_t)L * 2 + half) * 16;
#pragma unroll
            for (int j4 = 0; j4 < 4; ++j4) ((float4*)(TV + o))[j4] = make_float4(v0[4 * j4], v0[4 * j4 + 1], v0[4 * j4 + 2], v0[4 * j4 + 3]); }
    }
    __syncthreads();
}
template <bool FUSED, bool LOCAL = false> __device__ __forceinline__ void ph_topk2(const Ctx& c, const float* TV, const int* TI, int* EIDX, float* GATE, int* AI, float* SUK, const float* SU, const float* SV, int lt0 = 0, int lt1 = 0) {
    int it0 = FUSED ? 32 * (c.bid * 4 + ((c.tid >> 5) & 3) + (c.nblk * 4) * (c.tid >> 7)) + (c.tid & 31) : c.bid * NTHR + c.tid;
    if (LOCAL) { const int lt = (c.tid >> 8) ? lt1 : lt0; it0 = ((lt >> 3) * 256 + (c.tid & 255)) * 8 + (lt & 7); }
    for (int it = it0; it < T * PH; it += (FUSED ? T * PH : c.nblk * NTHR)) {
        float v1[16], v2[16]; int i1[16], i2[16];
#pragma unroll
        for (int j4 = 0; j4 < 4; ++j4) {
            const uint4 a = ((const uint4*)(TV + (size_t)it * 32))[j4], b = ((const uint4*)(TV + (size_t)it * 32 + 16))[j4];
            const unsigned aw[4] = {a.x, a.y, a.z, a.w}, bw[4] = {b.x, b.y, b.z, b.w};
#pragma unroll
            for (int k = 0; k < 4; ++k) { v1[4 * j4 + k] = __uint_as_float(aw[k] & ~127u); i1[4 * j4 + k] = (int)(aw[k] & 127u); v2[4 * j4 + k] = __uint_as_float(bw[k] & ~127u); i2[4 * j4 + k] = (int)(bw[k] & 127u); } }
        float cv[16]; int ci[16];
#pragma unroll
        for (int j = 0; j < 16; ++j) { cv[j] = -INFINITY; ci[j] = 0; }
#pragma unroll
        for (int a = 0; a < 16; ++a)
#pragma unroll
            for (int b = 0; b < 16; ++b)
                if ((a + 1) * (b + 1) <= 16) tk_insert(cv, ci, v1[a] + v2[b], i1[a] * NKEYS + i2[b]);
        float sum = 0.f, e[16];
#pragma unroll
        for (int j = 0; j < 16; ++j) { e[j] = __expf(cv[j] - cv[0]); sum += e[j]; }
        const float rs = 1.f / sum;
#pragma unroll
        for (int j = 0; j < 16; ++j) { e[j] = e[j] * rs * SV[ci[j]]; cv[j] = SU[ci[j]]; }
#pragma unroll
        for (int j4 = 0; j4 < 4; ++j4) { ((int4*)(EIDX + (size_t)it * 16))[j4] = make_int4(ci[4 * j4], ci[4 * j4 + 1], ci[4 * j4 + 2], ci[4 * j4 + 3]);
            ((uint4*)(GATE + (size_t)it * 16))[j4] = make_uint4(pk2(e[4 * j4], cv[4 * j4]), pk2(e[4 * j4 + 1], cv[4 * j4 + 1]), pk2(e[4 * j4 + 2], cv[4 * j4 + 2]), pk2(e[4 * j4 + 3], cv[4 * j4 + 3])); }
#pragma unroll
        for (int j4 = 0; j4 < 4; ++j4) ((int4*)(AI + (size_t)it * 16))[j4] = make_int4(0, 0, 0, 0);
    }
}

__device__ __forceinline__ float wave_sum_dpp63(float v) {
    v += __builtin_bit_cast(float, __builtin_amdgcn_update_dpp(0, __builtin_bit_cast(int, v), 0xB1, 0xF, 0xF, false));
    v += __builtin_bit_cast(float, __builtin_amdgcn_update_dpp(0, __builtin_bit_cast(int, v), 0x4E, 0xF, 0xF, false));
    v += __builtin_bit_cast(float, __builtin_amdgcn_update_dpp(0, __builtin_bit_cast(int, v), 0x141, 0xF, 0xF, false));
    v += __builtin_bit_cast(float, __builtin_amdgcn_update_dpp(0, __builtin_bit_cast(int, v), 0x140, 0xF, 0xF, false));
    v += __builtin_bit_cast(float, __builtin_amdgcn_update_dpp(0, __builtin_bit_cast(int, v), 0x142, 0xA, 0xF, false));
    v += __builtin_bit_cast(float, __builtin_amdgcn_update_dpp(0, __builtin_bit_cast(int, v), 0x143, 0xC, 0xF, false));
    return v;
}
__device__ __forceinline__ int wave_sum_dpp63_i(int v) {
    v += __builtin_amdgcn_update_dpp(0, v, 0xB1, 0xF, 0xF, false);
    v += __builtin_amdgcn_update_dpp(0, v, 0x4E, 0xF, 0xF, false);
    v += __builtin_amdgcn_update_dpp(0, v, 0x141, 0xF, 0xF, false);
    v += __builtin_amdgcn_update_dpp(0, v, 0x140, 0xF, 0xF, false);
    v += __builtin_amdgcn_update_dpp(0, v, 0x142, 0xA, 0xF, false);
    v += __builtin_amdgcn_update_dpp(0, v, 0x143, 0xC, 0xF, false);
    return v;
}
template <bool DRY> __device__ __forceinline__ void ph_peer_u(const Ctx& c, const unsigned char* XN8, const int* EIDX, int* AI, const unsigned char* EU) {
    const int j = c.bid & 7, wp = (c.bid >> 3) * NWAVES + c.wave, NWP = (c.nblk >> 3) * NWAVES, NT = T / NWP;
    const int rr = c.lane >> 3, cc = c.lane & 7;
    LAS int* el = (LAS int*)((LAS unsigned char*)c.lds + c.wave * 5120);
    const unsigned char* Up = EU + (size_t)j * NEXP * 128;
    const unsigned cofs = 16u * (unsigned)cc;
#define PU_TOK(n) (wp + ((n) < NT ? (n) : NT - 1) * NWP)
#define PU_META(E0, E1, H, n) do { const unsigned t_ = (unsigned)PU_TOK(n); E0 = EIDX[t_ * 128u + (unsigned)c.lane]; E1 = EIDX[t_ * 128u + 64u + (unsigned)c.lane]; H = *(const uint4*)(XN8 + (t_ * (unsigned)D + 128u * (unsigned)j + cofs)); } while (0)
#define PU_STAGE(R, HS, E0, E1, H) do { el[c.lane] = E0; el[64 + c.lane] = E1; HS = H; \
        _Pragma("unroll") for (int i = 0; i < 16; ++i) { const unsigned e = (unsigned)el[i * 8 + rr]; R[i] = *(const uint4*)(Up + (e * 128u + cofs)); } } while (0)
#define PU_COMPUTE(R, HS, n) do { int resA = 0, resB = 0; \
        _Pragma("unroll") for (int i = 0; i < 16; ++i) { \
            int d = __builtin_amdgcn_sdot4((int)R[i].x, (int)HS.x, 0, false); d = __builtin_amdgcn_sdot4((int)R[i].y, (int)HS.y, d, false); \
            d = __builtin_amdgcn_sdot4((int)R[i].z, (int)HS.z, d, false); d = __builtin_amdgcn_sdot4((int)R[i].w, (int)HS.w, d, false); \
            d += __builtin_amdgcn_update_dpp(0, d, 0xB1, 0xF, 0xF, false); d += __builtin_amdgcn_update_dpp(0, d, 0x4E, 0xF, 0xF, false); d += __builtin_amdgcn_update_dpp(0, d, 0x141, 0xF, 0xF, false); \
            if (i < 8) resA = (cc == i) ? d : resA; else resB = (cc == i - 8) ? d : resB; } \
        if (DRY) { asm volatile("" :: "v"(resA), "v"(resB)); } \
        else { int* ap = AI + ((unsigned)PU_TOK(n) * 128u + (unsigned)(8 * cc + rr)); \
            __hip_atomic_fetch_add(ap, resA, __ATOMIC_RELAXED, __HIP_MEMORY_SCOPE_AGENT); __hip_atomic_fetch_add(ap + 64, resB, __ATOMIC_RELAXED, __HIP_MEMORY_SCOPE_AGENT); } } while (0)
    int mE0, mE1; uint4 mH, hA, hB; uint4 rA[16], rB[16];
    PU_META(mE0, mE1, mH, 0);
    PU_STAGE(rA, hA, mE0, mE1, mH); PU_META(mE0, mE1, mH, 1);
    for (int n = 0; n < NT; n += 2) {
        PU_STAGE(rB, hB, mE0, mE1, mH); PU_META(mE0, mE1, mH, n + 2);
        PU_COMPUTE(rA, hA, n);
        PU_STAGE(rA, hA, mE0, mE1, mH); PU_META(mE0, mE1, mH, n + 3);
        PU_COMPUTE(rB, hB, n + 1);
    }
#undef PU_TOK
#undef PU_META
#undef PU_STAGE
#undef PU_COMPUTE
}
template <bool DRY> __device__ __forceinline__ void ph_peer_v(const Ctx& c, const int* EIDX, const float* GATE, const int* AI, const float* SH, const float* SUK, const unsigned char* EV, bf16* XB) {
    const int j = c.bid & 7, wp = (c.bid >> 3) * NWAVES + c.wave, NWP = (c.nblk >> 3) * NWAVES;
    const int rr = c.lane >> 3, cc = c.lane & 7;
    typedef unsigned u32x2v __attribute__((ext_vector_type(2)));
    typedef float f32x2v __attribute__((ext_vector_type(2)));
    LAS u32x2v* ew = (LAS u32x2v*)((LAS unsigned char*)c.lds + c.wave * 5120);
    LAS float* red = (LAS float*)((LAS unsigned char*)c.lds + c.wave * 5120 + 1024);
    const unsigned char* Vp = EV + (size_t)j * NEXP * 128 + 16 * cc;
    int eB0 = EIDX[(size_t)wp * 128 + c.lane], eB1 = EIDX[(size_t)wp * 128 + 64 + c.lane];
    const unsigned* GS = (const unsigned*)GATE;
    unsigned gB0 = GS[(size_t)wp * 128 + c.lane], gB1 = GS[(size_t)wp * 128 + 64 + c.lane];
    int aB0 = AI[(size_t)wp * 128 + c.lane], aB1 = AI[(size_t)wp * 128 + 64 + c.lane];
    float shB = SH[wp];
    for (int t = wp; t < T; t += NWP) {
        const int e0 = eB0, e1 = eB1;
        const float w0 = gelu_fast((float)aB0 * bf_hi(gB0) * shB) * bf_lo(gB0), w1 = gelu_fast((float)aB1 * bf_hi(gB1) * shB) * bf_lo(gB1);
        { const size_t o1 = (size_t)((t + NWP < T) ? t + NWP : t) * 128 + c.lane;
          eB0 = EIDX[o1]; eB1 = EIDX[o1 + 64]; gB0 = GS[o1]; gB1 = GS[o1 + 64]; aB0 = AI[o1]; aB1 = AI[o1 + 64]; shB = SH[o1 >> 7]; }
        unsigned* xp = (unsigned*)(XB + (size_t)t * D + 128 * j) + c.lane;
        ew[c.lane] = (u32x2v){(unsigned)e0, __float_as_uint(w0)}; ew[64 + c.lane] = (u32x2v){(unsigned)e1, __float_as_uint(w1)};
        f32x2v acc[8];
#pragma unroll
        for (int m = 0; m < 8; ++m) acc[m] = (f32x2v){0.f, 0.f};
        uint4 r[16]; float wv[16];
#pragma unroll
        for (int i = 0; i < 16; ++i) { const u32x2v p = ew[i * 8 + rr]; wv[i] = __uint_as_float(p.y); r[i] = *(const uint4*)(Vp + (size_t)p.x * 128); }
#pragma unroll
        for (int i = 0; i < 16; ++i) { const int dw[4] = {(int)r[i].x, (int)r[i].y, (int)r[i].z, (int)r[i].w}; const f32x2v ww = (f32x2v){wv[i], wv[i]};
#pragma unroll
            for (int q = 0; q < 4; ++q) {
                acc[2 * q] = __builtin_elementwise_fma(ww, __builtin_amdgcn_cvt_pk_f32_fp8(dw[q], false), acc[2 * q]);
                acc[2 * q + 1] = __builtin_elementwise_fma(ww, __builtin_amdgcn_cvt_pk_f32_fp8(dw[q], true), acc[2 * q + 1]); } }
#pragma unroll
        for (int q = 0; q < 4; ++q) *(LAS pg8::f32x4*)(red + rr * 128 + 16 * cc + 4 * q) = (pg8::f32x4){acc[2 * q].x, acc[2 * q].y, acc[2 * q + 1].x, acc[2 * q + 1].y};
        f32x2v sum = (f32x2v){0.f, 0.f};
#pragma unroll
        for (int q = 0; q < 8; ++q) sum += *(const LAS f32x2v*)(red + q * 128 + 2 * c.lane);
        const unsigned xw = *xp; float2 x = make_float2(bf_lo(xw), bf_hi(xw));
        x.x += sum.x; x.y += sum.y; if (DRY) { asm volatile("" :: "v"(x.x), "v"(x.y)); } else *xp = pk2(x.x, x.y);
    }
}

constexpr int PH_PER_LAYER = 10, N_PHASES = DEPTH * PH_PER_LAYER + 2;
struct Args { const float* in[16]; float* out; unsigned char* ws; int ph_lo, ph_hi; };

__global__ void __launch_bounds__(NTHR, 2) fwd_kernel(Args args) {
    extern __shared__ __attribute__((aligned(16))) unsigned char lds_raw[];
#define MKCTX() Ctx c; { const int t_ = tid_now(); c.tid = t_; c.lane = t_ & 63; c.wave = __builtin_amdgcn_readfirstlane(t_ >> 6); c.bid = blockIdx.x; c.nblk = gridDim.x; c.lds = (float*)lds_raw; }
    volatile LAS unsigned* MISC = (volatile LAS unsigned*)((LAS unsigned char*)lds_raw + MISC_OFF);
    { const int t0_ = threadIdx.x;
      if (t0_ < 32) MISC[t0_] = 0u;
      if ((t0_ & 63) == 0) ((volatile LAS int*)(unsigned)WTAB_OFF)[(unsigned)__builtin_amdgcn_s_getreg((5 << 11) | 4) & 63u] = t0_ >> 6; }
    __syncthreads();
    unsigned char* ws = args.ws;
    XcdBarrier bar; bar.bar = (unsigned*)(ws + WS_CTL) + CW_BAR; bar.x = 0; bar.st = nullptr;
    const bool multi = (args.ph_hi - args.ph_lo) > 1;
    if (multi) bar = xcd_barrier_post((unsigned*)(ws + WS_CTL) + CW_BAR, MISC + 8);

#define WSPTRS() const __attribute__((address_space(4))) Args* ka = (const __attribute__((address_space(4))) Args*)__builtin_amdgcn_kernarg_segment_ptr(); asm volatile("" : "+s"(ka)); \
    unsigned char* wsl = ka->ws; const float* x = ka->in[0]; \
    float* ZF = (float*)(wsl + WS_ZF); int* EIDX = (int*)(wsl + WS_EIDX); float* GATE = (float*)(wsl + WS_GATE); float* VN = (float*)(wsl + WS_VN); \
    bf16* XN = (bf16*)(wsl + WS_XN); bf16* MIXN = (bf16*)(wsl + WS_MIXN); bf16* WT = (bf16*)(wsl + WS_W); bf16* ZB = (bf16*)(wsl + WS_ZB); \
    unsigned char* EU = wsl + WS_EU; unsigned char* EV = wsl + WS_EV; float* ES = (float*)(wsl + WS_ES); unsigned char* XN8 = wsl + WS_XN8; float* SH = (float*)(wsl + WS_SH); \
    int* AI = (int*)(wsl + WS_AI); float* SUK = (float*)(wsl + WS_SUK); unsigned long long* RSQ = (unsigned long long*)(wsl + WS_RSQ); unsigned long long* KN2 = (unsigned long long*)(wsl + WS_KN2); float* MIX = (float*)(wsl + WS_MIX); bf16* XB = (bf16*)(wsl + WS_XB); \
    LAS unsigned char* ldsp = (LAS unsigned char*)lds_raw; const int G = gridDim.x; \
    (void)x; (void)ZF; (void)EIDX; (void)GATE; (void)VN; (void)XN; (void)MIXN; (void)WT; (void)ZB; (void)EU; (void)EV; (void)ES; (void)XN8; (void)SH; (void)AI; (void)SUK; (void)RSQ; (void)KN2; (void)MIX; (void)XB; (void)ldsp; (void)G;
#ifndef PROBE_DUP
#define PROBE_DUP 0
#endif
#define DUP(flag, body) do { body; if (PROBE_DUP & (flag)) { body; } } while (0)
#define COMMA ,
#define RUN(k, body) do { const int k_ = (k); if (args.ph_lo <= k_ && k_ < args.ph_hi) { { MKCTX(); WSPTRS(); body; } if (k_ + 1 < args.ph_hi) xcd_barrier(bar); } } while (0)
    RUN(0, { { const WeightJob WJ0_{ka->in[2] COMMA ka->in[9] COMMA ka->in[11] COMMA ka->in[8] COMMA WT COMMA 0 COMMA WI_IN}; DUP(256, ph_prologue(c, WJ0_)); } ph_rmsnorm_bf16<false COMMA false>(c, x, ka->in[1], XN, nullptr, nullptr, RSQ, KN2); });
#define GEMM_PH(EpiT, Einit, Aptr, Bptr, NN) do { pg8::Gemm g_{Aptr, Bptr, T, NN, D}; pg8::StaticOrder S_; S_.init(T, NN, G, (int)blockIdx.x); \
        EpiT E_ Einit; pg8::gemm_phase<EpiT, pg8::StaticOrder, PG8_ALIGN, PG8_SP2>(ldsp, g_, S_, E_); } while (0)
#define LAYER(l) { \
        const int p0 = 1 + l * PH_PER_LAYER; \
        if (l > 0) RUN(p0 + 0, ph_rmsnorm_bf16<false COMMA true>(c, XB, ka->in[1] + (size_t)l * D, XN, nullptr, nullptr, RSQ, KN2)); \
        RUN(p0 + 1, DUP(8, GEMM_PH(EpiZ, {ZB COMMA ZF COMMA attn_body::C2 COMMA KN2}, XN, (WT + (size_t)l * WROWS_PER_LAYER * D), NIN_PAD))); \
        RUN(p0 + 2, { DUP(4, { const attn_body::AttnTensors AT_{(const attn_body::bf16*)ZB + NQ COMMA (const attn_body::bf16*)ZB + NK COMMA (const attn_body::bf16*)ZB + NV COMMA (attn_body::bf16*)MIXN COMMA ZF COMMA ka->in[3] + l * NH COMMA RSQ COMMA KN2}; const QuantJob QJ_{ka->in[13] COMMA ka->in[14] COMMA EU COMMA EV COMMA ES COMMA l}; const WeightJob WJ_{ka->in[2] COMMA ka->in[9] COMMA ka->in[11] COMMA ka->in[8] COMMA WT COMMA (l == 0 ? WI_IN : WI_L + WI_IN) COMMA (l == 0 ? WI_L + WI_IN : 2 * WI_L)}; \
            if ((G & 7) == 0) { attn_body::attn_phase_dyn((char*)lds_raw COMMA AT_ COMMA (unsigned*)(wsl + WS_CTL) + 20480 + 16 * l COMMA (int)blockIdx.x COMMA QJ_ COMMA WJ_); } else { { const int t_ = tid_now(); const int wv_ = __builtin_amdgcn_readfirstlane(t_ >> 6); for (int qu_ = (int)blockIdx.x; qu_ < QUANT_UNITS; qu_ += G) quant_unit(QJ_ COMMA qu_ COMMA wv_ COMMA t_ & 63); for (int wu_ = (int)blockIdx.x; wu_ < weight_units(WJ_); wu_ += G) weight_unit(WJ_ COMMA wu_ COMMA ldsp COMMA wv_ COMMA t_ & 63); __syncthreads(); } const attn_body::StaticOrder SA_(G COMMA (int)blockIdx.x); attn_body::attn_phase<attn_body::StaticOrder>((char*)lds_raw COMMA AT_ COMMA SA_); } }); \
            { MKCTX(); DUP(16, for (int u_ = c.bid; u_ < 2 * T / CHUNK; u_ += c.nblk) mixlocal_unit(c, u_, ZB, ka->in[5] + (size_t)l * 4 * CHUNK * CHUNK, ka->in[6] + l * 4 * CHUNK, ka->in[4] + l * 256, ka->in[7] + l * 3 * 256, ka->in[8] + (size_t)l * D, MIXN)); } }); \
        RUN(p0 + 3, GEMM_PH(EpiOut, {XB COMMA D COMMA (l == 0 ? (const void*)x : (const void*)XB) COMMA (l == 0 ? 0 : 1) COMMA RSQ}, MIXN, (WT + (size_t)l * WROWS_PER_LAYER * D) + (size_t)NIN_PAD * D, D)); \
        RUN(p0 + 4, DUP(1, ph_rmsnorm_bf16<true COMMA true>(c, XB, ka->in[10] + (size_t)l * D, XN, XN8, SH))); \
        if ((int)gridDim.x * 2 == (T / 256) * (2048 / 256)) RUN(p0 + 5, { GEMM_PH(pg8::EpiBf16<0>, {ZB COMMA 2048 COMMA nullptr COMMA 0 COMMA 0 COMMA 1.f}, XN, (WT + (size_t)l * WROWS_PER_LAYER * D) + (size_t)(NIN_PAD + D) * D, 2048); \
            pg8::StaticOrder SQ_; SQ_.init(T, 2048, G, (int)blockIdx.x); pg8::Unit u0_; pg8::Unit u1_; SQ_.next(0, u0_); SQ_.next(1, u1_); const int lt0_ = u0_.pm * 8 + u0_.pn; const int lt1_ = u1_.pm * 8 + u1_.pn; \
            asm volatile("s_waitcnt vmcnt(0)" ::: "memory"); __syncthreads(); \
            ph_topk1_mfma<true>(c, ZB, ka->in[12] + (size_t)l * 2 * NKEYS * DHALF, VN, (int*)MIX, lt0_, lt1_); \
            asm volatile("s_waitcnt vmcnt(0)" ::: "memory"); __syncthreads(); \
            ph_topk2<true COMMA true>(c, VN, (const int*)MIX, EIDX, GATE, AI, SUK, ES + l * NEXP, ES + (DEPTH + l) * NEXP, lt0_, lt1_); }); \
        if ((int)gridDim.x * 2 != (T / 256) * (2048 / 256)) RUN(p0 + 5, DUP(8, GEMM_PH(pg8::EpiBf16<0>, {ZB COMMA 2048 COMMA nullptr COMMA 0 COMMA 0 COMMA 1.f}, XN, (WT + (size_t)l * WROWS_PER_LAYER * D) + (size_t)(NIN_PAD + D) * D, 2048))); \
        if ((int)gridDim.x * 2 != (T / 256) * (2048 / 256)) RUN(p0 + 6, { DUP(2, ph_topk1_mfma<false>(c, ZB, ka->in[12] + (size_t)l * 2 * NKEYS * DHALF, VN, (int*)MIX)); \
            if (c.nblk * NWAVES * 4 == T * PH * 2 / 32) { asm volatile("s_waitcnt vmcnt(0)" ::: "memory"); __syncthreads(); ph_topk2<true>(c, VN, (const int*)MIX, EIDX, GATE, AI, SUK, ES + l * NEXP, ES + (DEPTH + l) * NEXP); } }); \
        if ((int)gridDim.x * 2 != (T / 256) * (2048 / 256) && (int)gridDim.x * NWAVES * 4 != T * PH * 2 / 32) RUN(p0 + 7, ph_topk2<false>(c, VN, (const int*)MIX, EIDX, GATE, AI, SUK, ES + l * NEXP, ES + (DEPTH + l) * NEXP)); \
        RUN(p0 + 8, if (PROBE_DUP & 64) ph_peer_u<true>(c, XN8, EIDX, AI, EU + (size_t)l * NEXP * D); ph_peer_u<false>(c, XN8, EIDX, AI, EU + (size_t)l * NEXP * D)); \
        RUN(p0 + 9, if (PROBE_DUP & 512) ph_peer_v<true>(c, EIDX, GATE, AI, SH, SUK, EV + (size_t)l * NEXP * D, XB); ph_peer_v<false>(c, EIDX, GATE, AI, SH, SUK, EV + (size_t)l * NEXP * D, XB)); \
    }
    LAYER(0)
    LAYER(1)
#undef LAYER
    RUN(1 + DEPTH * PH_PER_LAYER, ph_rmsnorm(c, XB, ka->in[15], ka->out));
#undef RUN
}

extern "C" void kernel_launch(void* const* d_in, const int* in_sizes, int n_in, void* d_out, int out_size, void* d_ws, size_t ws_size, hipStream_t stream) {
    static int grid = 0;
    if (grid == 0) {
        if (n_in != 16 || out_size != T * D || ws_size < WS_END) { fprintf(stderr, "kernel_launch: unexpected shapes (n_in %d out %d ws %zu)\n", n_in, out_size, ws_size); grid = -1; return; }
        int dev = 0, cus = 0, per_cu = 0;
        hipGetDevice(&dev); hipDeviceGetAttribute(&cus, hipDeviceAttributeMultiprocessorCount, dev);
        hipFuncSetAttribute((const void*)fwd_kernel, hipFuncAttributeMaxDynamicSharedMemorySize, LDS_BYTES);
        hipOccupancyMaxActiveBlocksPerMultiprocessor(&per_cu, (const void*)fwd_kernel, NTHR, LDS_BYTES);
        (void)hipGetLastError();
        if (per_cu < 1) { fprintf(stderr, "kernel_launch: occupancy query says %d\n", per_cu); }
        grid = cus;
    }
    if (grid < 0) return;
    hipMemsetAsync((char*)d_ws + WS_CTL, 0, CTL_ZERO_BYTES, stream);
    Args a{};
    for (int i = 0; i < 16; ++i) a.in[i] = (const float*)d_in[i];
    a.out = (float*)d_out; a.ws = (unsigned char*)d_ws;
    if (MK_N_LAUNCHES == 1) {
        a.ph_lo = 0; a.ph_hi = N_PHASES;
        hipLaunchKernelGGL(fwd_kernel, dim3(grid), dim3(NTHR), LDS_BYTES, stream, a);
    } else {
        for (int ph = 0; ph < N_PHASES; ++ph) { a.ph_lo = ph; a.ph_hi = ph + 1; hipLaunchKernelGGL(fwd_kernel, dim3(grid), dim3(NTHR), LDS_BYTES, stream, a); }
    }
}
```
